# Optimizing an MI355X kernel written in HIP

```python
import jax
import jax.numpy as jnp
from jax import lax
import numpy as np


D_MODEL = 1024
BATCH = 4
SEQ = 8192
DEPTH = 2

GRID_W = 64
CTX_LEN = 256
EPS = 1e-6
NA_HEADS = 8
NA_HEAD_DIM = 64
NA_WIDTH = NA_HEADS * NA_HEAD_DIM
NA_WIN_R = 8
NA_WIN_C = 16
NA_QBLOCK_C = 16
NA_KBAND_C = NA_QBLOCK_C + NA_WIN_C
POOL_WINDOWS = (2, 4, 8, 16)
POOL_GROUP = 128
POOL_WIDTH = POOL_GROUP * len(POOL_WINDOWS)
MLA_HEADS = 8
MLA_NOPE = 64
MLA_ROPE = 32
MLA_V = 64
MLA_Q_RANK = 512
MLA_KV_RANK = 256
MLA_QBLOCK = 128
ROPE_BASE = 10000.0
N_BRANCH = 3
BRANCH_W = 512
D_FF = 2816
CONV_W = 3
IN_SIZES = (NA_WIDTH, NA_WIDTH, NA_WIDTH, POOL_WIDTH, MLA_Q_RANK, MLA_KV_RANK, MLA_ROPE, N_BRANCH * D_MODEL)
IN_COLS = 3 * NA_WIDTH + POOL_WIDTH + MLA_Q_RANK + MLA_KV_RANK + MLA_ROPE + N_BRANCH * D_MODEL

kernel_name = 'hybrid_dit_na_pool_mla_block'


def rms_norm(x, g):
    xf = x.astype(jnp.float32)
    y = xf * lax.rsqrt(jnp.mean(xf * xf, axis=-1, keepdims=True) + EPS)
    return (y * g.astype(jnp.float32)).astype(x.dtype)


def modulate(h, shift, scale):
    return h * (1 + scale) + shift


def split_cols(z, sizes):
    outs, o = [], 0
    for s in sizes:
        outs.append(z[..., o:o + s])
        o += s
    return outs


def axial_angles(n_tok, dim):
    n_freq = dim // 4
    inv = ROPE_BASE ** (-jnp.arange(n_freq, dtype=jnp.float32) / n_freq)
    t = jnp.arange(n_tok, dtype=jnp.int32)
    row = (t // GRID_W).astype(jnp.float32)
    col = (t % GRID_W).astype(jnp.float32)
    return row[:, None] * inv[None, :], col[:, None] * inv[None, :]


def _rot_half(x, ang):
    x1, x2 = jnp.split(x, 2, axis=-1)
    cos, sin = jnp.cos(ang), jnp.sin(ang)
    return jnp.concatenate([x1 * cos - x2 * sin, x1 * sin + x2 * cos], axis=-1)


def apply_axial_rope(x, ang_r, ang_c):
    xf = x.astype(jnp.float32)
    xr, xc = jnp.split(xf, 2, axis=-1)
    return jnp.concatenate([_rot_half(xr, ang_r), _rot_half(xc, ang_c)], axis=-1).astype(x.dtype)


def dwconv_centred(u, w, b):
    L = u.shape[1]
    pad = CONV_W // 2
    up = jnp.pad(u, ((0, 0), (pad, pad), (0, 0)))
    y = b
    for j in range(CONV_W):
        y = y + up[:, j:j + L] * w[j]
    return y


def pool_mixer(u, w_grp, scale):
    B, L, _ = u.shape
    uf = u.astype(jnp.float32)
    cs = jnp.concatenate([jnp.zeros((B, 1, POOL_WIDTH), jnp.float32), jnp.cumsum(uf, axis=1)], axis=1)
    t = jnp.arange(L)
    diffs = []
    for gi, win in enumerate(POOL_WINDOWS):
        lo = jnp.clip(t - win // 2, 0, L)
        hi = jnp.clip(t + win // 2, 0, L)
        sl = slice(gi * POOL_GROUP, (gi + 1) * POOL_GROUP)
        csg = cs[..., sl]
        cnt = (hi - lo).astype(jnp.float32)[None, :, None]
        diffs.append((csg[:, hi] - csg[:, lo]) / cnt - uf[..., sl])
    d = jnp.stack(diffs, axis=2)
    y = jnp.einsum('blgi,gio->blgo', d, w_grp.astype(jnp.float32)).reshape(B, L, POOL_WIDTH)
    return (y * scale.astype(jnp.float32)).astype(u.dtype)


def dense_attn(q, k, v):
    s = jnp.einsum('bqhd,bkhd->bhqk', q, k, preferred_element_type=jnp.float32) * (q.shape[-1] ** -0.5)
    p = jax.nn.softmax(s, axis=-1).astype(v.dtype)
    return jnp.einsum('bhqk,bkhd->bqhd', p, v)


def na_latent(q, k, v, k_ctx, v_ctx, rpb):
    B, S, H, dh = q.shape
    rows = S // GRID_W
    kr = min(NA_WIN_R, rows)
    ncb = GRID_W // NA_QBLOCK_C
    scale = dh ** -0.5
    qcol = jnp.arange(GRID_W).reshape(ncb, NA_QBLOCK_C)
    win0 = jnp.clip(qcol - NA_WIN_C // 2, 0, GRID_W - NA_WIN_C)
    band0 = jnp.clip(jnp.arange(ncb) * NA_QBLOCK_C - NA_WIN_C // 2, 0, GRID_W - NA_KBAND_C)
    kcol = band0[:, None] + jnp.arange(NA_KBAND_C)[None, :]
    kc3 = kcol[:, None, :]
    in_win = (kc3 >= win0[..., None]) & (kc3 < win0[..., None] + NA_WIN_C)
    rel_c = jnp.clip(kc3 - qcol[..., None] + NA_WIN_C - 1, 0, 2 * NA_WIN_C - 2)
    kg = k.reshape(B, rows, GRID_W, H, dh)
    vg = v.reshape(B, rows, GRID_W, H, dh)
    qg = jnp.moveaxis(q.reshape(B, rows, ncb, NA_QBLOCK_C, H, dh), 1, 0)
    n_win = kr * NA_KBAND_C

    def one_row(args):
        r, q_r = args
        r0 = jnp.clip(r - kr // 2, 0, rows - kr)
        k_rows = lax.dynamic_slice_in_dim(kg, r0, kr, axis=1)
        v_rows = lax.dynamic_slice_in_dim(vg, r0, kr, axis=1)
        k_nb = k_rows[:, :, kcol]
        v_nb = v_rows[:, :, kcol]
        rel_r = r0 + jnp.arange(kr) - r + NA_WIN_R - 1
        bias = rpb[:, rel_r[None, None, :, None], rel_c[:, :, None, :]]
        s_win = jnp.einsum('bjqhd,bkjchd->bhjqkc', q_r, k_nb, preferred_element_type=jnp.float32) * scale
        s_win = jnp.where(in_win[:, :, None, :], s_win + bias.astype(jnp.float32), -jnp.inf)
        s_ctx = jnp.einsum('bjqhd,bnhd->bhjqn', q_r, k_ctx, preferred_element_type=jnp.float32) * scale
        s = jnp.concatenate([s_win.reshape(B, H, ncb, NA_QBLOCK_C, n_win), s_ctx], axis=-1)
        p = jax.nn.softmax(s, axis=-1).astype(v.dtype)
        p_win = p[..., :n_win].reshape(B, H, ncb, NA_QBLOCK_C, kr, NA_KBAND_C)
        p_ctx = p[..., n_win:]
        return (jnp.einsum('bhjqkc,bkjchd->bjqhd', p_win, v_nb)
                + jnp.einsum('bhjqn,bnhd->bjqhd', p_ctx, v_ctx))

    out = lax.map(one_row, (jnp.arange(rows), qg))
    return jnp.moveaxis(out, 0, 1).reshape(B, S, H, dh)


def mla_attend(q_nope, q_rope, k_nope, k_rope, v):
    B, L, H, _ = q_nope.shape
    nb = L // MLA_QBLOCK
    scale = (MLA_NOPE + MLA_ROPE) ** -0.5

    def blk(args):
        qn, qr = args
        s = (jnp.einsum('bqhd,bthd->bhqt', qn, k_nope, preferred_element_type=jnp.float32)
             + jnp.einsum('bqhd,btd->bhqt', qr, k_rope, preferred_element_type=jnp.float32)) * scale
        p = jax.nn.softmax(s, axis=-1).astype(v.dtype)
        return jnp.einsum('bhqt,bthd->bqhd', p, v)

    def to_blocks(a):
        return jnp.moveaxis(a.reshape(B, nb, MLA_QBLOCK, *a.shape[2:]), 1, 0)

    out = lax.map(blk, (to_blocks(q_nope), to_blocks(q_rope)))
    return jnp.moveaxis(out, 0, 1).reshape(B, L, H, MLA_V)


def project_stream(h, lp, rope_angles):
    B, L, _ = h.shape
    q, k, v, u, cq, ckv, kr, g = split_cols(h @ lp['w_in'], IN_SIZES)
    qm = (rms_norm(cq, lp['mla_q_norm']) @ lp['w_uq']).reshape(B, L, MLA_HEADS, MLA_NOPE + MLA_ROPE)
    kvm = (rms_norm(ckv, lp['mla_kv_norm']) @ lp['w_ukv']).reshape(B, L, MLA_HEADS, MLA_NOPE + MLA_V)
    q_rope = qm[..., MLA_NOPE:]
    if rope_angles is not None:
        ang_r, ang_c = rope_angles
        q_rope = apply_axial_rope(q_rope, ang_r[:, None, :], ang_c[:, None, :])
        kr = apply_axial_rope(kr, ang_r, ang_c)
    return {
        'na_q': q.reshape(B, L, NA_HEADS, NA_HEAD_DIM),
        'na_k': k.reshape(B, L, NA_HEADS, NA_HEAD_DIM),
        'na_v': v.reshape(B, L, NA_HEADS, NA_HEAD_DIM),
        'pool_u': u,
        'q_nope': qm[..., :MLA_NOPE],
        'q_rope': q_rope,
        'k_nope': kvm[..., :MLA_NOPE],
        'v': kvm[..., MLA_NOPE:],
        'k_rope': kr,
        'gates': g,
    }


def merge_branches(o_na, o_pool, o_mla, gate_logits, lp):
    B, L, _ = o_pool.shape
    br = jnp.stack([o_na.reshape(B, L, BRANCH_W), o_pool, o_mla.reshape(B, L, BRANCH_W)], axis=2)
    proj = jnp.einsum('blki,kid->blkd', br, lp['w_branch'])
    gates = jax.nn.sigmoid(gate_logits.astype(jnp.float32)).astype(proj.dtype).reshape(B, L, N_BRANCH, D_MODEL)
    return jnp.sum(gates * proj, axis=2) @ lp['w_o']


def conv_ffn(h, lp):
    u = dwconv_centred(h @ lp['w_up'], lp['conv_w'], lp['conv_b'])
    a, b = jnp.split(u, 2, axis=-1)
    return (jax.nn.gelu(a, approximate=True) * b) @ lp['w_down']


def hybrid_layer(x, xc, c, c_ctx, lp, rope_angles, last):
    mod = (jax.nn.silu(c) @ lp['w_ada'] + lp['b_ada'])[:, None, :]
    mod_c = jax.nn.silu(c_ctx) @ lp['w_ada'] + lp['b_ada']
    sh1, sc1, g1, sh2, sc2, g2 = jnp.split(mod, 6, axis=-1)
    csh1, csc1, cg1, csh2, csc2, cg2 = jnp.split(mod_c, 6, axis=-1)

    h = modulate(rms_norm(x, lp['norm_pre1']), sh1, sc1)
    hc = modulate(rms_norm(xc, lp['norm_pre1']), csh1, csc1)
    P = project_stream(h, lp, rope_angles)
    C = project_stream(hc, lp, None)

    o_na = na_latent(P['na_q'], P['na_k'], P['na_v'], C['na_k'], C['na_v'], lp['na_rpb'])
    o_pool = pool_mixer(P['pool_u'], lp['pool_w'], lp['pool_scale'])
    k_nope_all = jnp.concatenate([C['k_nope'], P['k_nope']], axis=1)
    k_rope_all = jnp.concatenate([C['k_rope'], P['k_rope']], axis=1)
    v_all = jnp.concatenate([C['v'], P['v']], axis=1)
    o_mla = mla_attend(P['q_nope'], P['q_rope'], k_nope_all, k_rope_all, v_all)
    y = merge_branches(o_na, o_pool, o_mla, P['gates'], lp)
    x = x + g1 * rms_norm(y, lp['norm_post1'])

    h2 = modulate(rms_norm(x, lp['norm_pre2']), sh2, sc2)
    x = x + g2 * rms_norm(conv_ffn(h2, lp), lp['norm_post2'])

    if last:
        return x, None
    oc_na = dense_attn(C['na_q'], C['na_k'], C['na_v'])
    oc_pool = pool_mixer(C['pool_u'], lp['pool_w'], lp['pool_scale'])
    oc_mla = mla_attend(C['q_nope'], C['q_rope'], C['k_nope'], C['k_rope'], C['v'])
    yc = merge_branches(oc_na, oc_pool, oc_mla, C['gates'], lp)
    xc = xc + cg1 * rms_norm(yc, lp['norm_post1'])
    hc2 = modulate(rms_norm(xc, lp['norm_pre2']), csh2, csc2)
    xc = xc + cg2 * rms_norm(conv_ffn(hc2, lp), lp['norm_post2'])
    return x, xc


def setup_inputs(seed: int = 0) -> dict:
    key = jax.random.key(seed)
    ks = jax.random.split(key, 24)
    f32 = jnp.float32

    def nrm(k, shape, s):
        return jax.random.normal(k, shape, f32) * s

    def gain(k, n):
        return 1.0 + 0.05 * jax.random.normal(k, (DEPTH, n), f32)

    return {
        'x': nrm(ks[0], (BATCH, SEQ, D_MODEL), 1.0),
        'c': nrm(ks[1], (BATCH, D_MODEL), 1.0),
        'ctx': nrm(ks[2], (BATCH, CTX_LEN, D_MODEL), 1.0),
        'c_ctx': nrm(ks[3], (D_MODEL,), 1.0),
        'w_ada': nrm(ks[4], (DEPTH, D_MODEL, 6 * D_MODEL), 0.5 * D_MODEL ** -0.5),
        'b_ada': nrm(ks[5], (DEPTH, 6 * D_MODEL), 0.02),
        'norm_pre1': gain(ks[6], D_MODEL),
        'norm_post1': gain(ks[7], D_MODEL),
        'norm_pre2': gain(ks[8], D_MODEL),
        'norm_post2': gain(ks[9], D_MODEL),
        'w_in': nrm(ks[10], (DEPTH, D_MODEL, IN_COLS), D_MODEL ** -0.5),
        'na_rpb': nrm(ks[11], (DEPTH, NA_HEADS, 2 * NA_WIN_R - 1, 2 * NA_WIN_C - 1), 0.1),
        'pool_w': nrm(ks[12], (DEPTH, len(POOL_WINDOWS), POOL_GROUP, POOL_GROUP), POOL_GROUP ** -0.5),
        'pool_scale': 1.0 + 0.1 * jax.random.normal(ks[13], (DEPTH, POOL_WIDTH), f32),
        'mla_q_norm': gain(ks[14], MLA_Q_RANK),
        'w_uq': nrm(ks[15], (DEPTH, MLA_Q_RANK, MLA_HEADS * (MLA_NOPE + MLA_ROPE)), MLA_Q_RANK ** -0.5),
        'mla_kv_norm': gain(ks[16], MLA_KV_RANK),
        'w_ukv': nrm(ks[17], (DEPTH, MLA_KV_RANK, MLA_HEADS * (MLA_NOPE + MLA_V)), MLA_KV_RANK ** -0.5),
        'w_branch': nrm(ks[18], (DEPTH, N_BRANCH, BRANCH_W, D_MODEL), BRANCH_W ** -0.5),
        'w_o': nrm(ks[19], (DEPTH, D_MODEL, D_MODEL), D_MODEL ** -0.5),
        'w_up': nrm(ks[20], (DEPTH, D_MODEL, 2 * D_FF), D_MODEL ** -0.5),
        'conv_w': nrm(ks[21], (DEPTH, CONV_W, 2 * D_FF), CONV_W ** -0.5),
        'conv_b': nrm(ks[22], (DEPTH, 2 * D_FF), 0.02),
        'w_down': nrm(ks[23], (DEPTH, D_FF, D_MODEL), D_FF ** -0.5),
    }


def reference(x, c, ctx, c_ctx, w_ada, b_ada, norm_pre1, norm_post1, norm_pre2, norm_post2,
              w_in, na_rpb, pool_w, pool_scale, mla_q_norm, w_uq, mla_kv_norm, w_ukv,
              w_branch, w_o, w_up, conv_w, conv_b, w_down):
    rope_angles = axial_angles(x.shape[1], MLA_ROPE)
    xc = ctx
    for l in range(DEPTH):
        lp = {
            'w_ada': w_ada[l], 'b_ada': b_ada[l],
            'norm_pre1': norm_pre1[l], 'norm_post1': norm_post1[l],
            'norm_pre2': norm_pre2[l], 'norm_post2': norm_post2[l],
            'w_in': w_in[l], 'na_rpb': na_rpb[l],
            'pool_w': pool_w[l], 'pool_scale': pool_scale[l],
            'mla_q_norm': mla_q_norm[l], 'w_uq': w_uq[l],
            'mla_kv_norm': mla_kv_norm[l], 'w_ukv': w_ukv[l],
            'w_branch': w_branch[l], 'w_o': w_o[l],
            'w_up': w_up[l], 'conv_w': conv_w[l], 'conv_b': conv_b[l], 'w_down': w_down[l],
        }
        x, xc = hybrid_layer(x, xc, c, c_ctx, lp, rope_angles, l == DEPTH - 1)
    return x
```

```cpp
#include <hip/hip_runtime.h>
#include <hip/hip_cooperative_groups.h>
#include <cstdio>
#include <cstdint>
namespace cg = cooperative_groups;

#ifndef ONE_LAUNCH
#define ONE_LAUNCH 1
#endif

typedef unsigned short bf16;
typedef __attribute__((ext_vector_type(8))) short bf16x8;
typedef __attribute__((ext_vector_type(4))) float f32x4;
#define DEV __device__ __forceinline__

constexpr int D = 1024, NB = 4, SEQ = 8192, CTX = 256;
constexpr int NLAT = NB * SEQ, NCTX = NB * CTX, MT = NLAT + NCTX;
constexpr int TALL = CTX + SEQ;
constexpr int INC = 5920, DFF = 2816;
constexpr float EPS = 1e-6f;

constexpr size_t SZ_WIN = (size_t)2944 * 1024 * 2, SZ_WG = (size_t)3072 * 1024 * 2, SZ_WUQ = (size_t)768 * 512 * 2,
                 SZ_WUKV = (size_t)1024 * 256 * 2, SZ_WBR = (size_t)3 * 1024 * 512 * 2, SZ_WO = (size_t)1024 * 1024 * 2,
                 SZ_WUP = (size_t)5632 * 1024 * 2, SZ_WDN = (size_t)1024 * 2816 * 2, SZ_WPL = (size_t)4 * 128 * 128 * 2;
constexpr size_t O_WIN = 0, O_WG = O_WIN + SZ_WIN, O_WUQ = O_WG + SZ_WG, O_WUKV = O_WUQ + SZ_WUQ, O_WBR = O_WUKV + SZ_WUKV,
                 O_WO = O_WBR + SZ_WBR, O_WUP = O_WO + SZ_WO, O_WDN = O_WUP + SZ_WUP, O_WPL = O_WDN + SZ_WDN, SZ_WL = O_WPL + SZ_WPL;
constexpr size_t WS_W = 0;
constexpr size_t WS_MOD = WS_W + 2 * SZ_WL;
constexpr size_t WS_XC = WS_MOD + 2 * 5 * 6144 * 4;
constexpr size_t WS_H = WS_XC + (size_t)NCTX * D * 4;
constexpr size_t SZ_R512 = (size_t)MT * 512 * 2;
constexpr size_t WS_A = WS_H + (size_t)MT * D * 2;
constexpr size_t WS_POOLU = WS_A;
constexpr size_t WS_CQ = WS_POOLU + SZ_R512;
constexpr size_t WS_CKV = WS_CQ + SZ_R512;
constexpr size_t WS_KR = WS_CKV + (size_t)MT * 256 * 2;
constexpr size_t WS_B = WS_KR + (size_t)MT * 32 * 4;
constexpr size_t WS_POOLD = WS_B;
constexpr size_t WS_QF = WS_POOLD + SZ_R512;
constexpr size_t WS_KF = WS_QF + (size_t)MT * 768 * 2;
constexpr size_t WS_VT = WS_KF + (size_t)NB * 8 * TALL * 96 * 2;
constexpr size_t WS_C = WS_VT + (size_t)NB * 8 * 64 * TALL * 2;
constexpr size_t WS_NAQ = WS_C;
constexpr size_t WS_NAK = WS_NAQ + SZ_R512;
constexpr size_t WS_NAVT = WS_NAK + SZ_R512;
constexpr size_t WS_END = WS_NAVT + (size_t)NB * 8 * 64 * TALL * 2;
constexpr size_t WS_GATED = WS_B;
constexpr size_t WS_Y = WS_C;
constexpr size_t WS_ACT = WS_A;
constexpr size_t WS_PB0 = WS_GATED, WS_PB1 = WS_GATED + (size_t)MT * D * 2, WS_PB2 = WS_NAK;
static_assert(WS_PB1 + (size_t)MT * D * 2 <= WS_C, "branch projections overflow region B");
constexpr size_t WS_BAR = (WS_END + 255) & ~(size_t)255;
constexpr size_t WS_TOTAL = WS_BAR + 3456 * 4;
static_assert(WS_ACT + (size_t)MT * DFF * 2 <= WS_C, "ACT overlaps Y");
static_assert(WS_GATED + (size_t)MT * D * 2 <= WS_KF, "GATED too big");

constexpr int LDS_GEMM = 73728;
constexpr int LDS_BYTES = LDS_GEMM + 2048;

struct Params {
  const float* in[24];
  float* out;
  unsigned char* ws;
  int ph_lo, ph_hi;
};

typedef __bf16 hbf2 __attribute__((ext_vector_type(2)));
typedef float f32x2 __attribute__((ext_vector_type(2)));
DEV bf16 f2bf(float f) { __bf16 h = (__bf16)f; return *(bf16*)&h; }
DEV float bf2f(bf16 h) { return __uint_as_float(((unsigned)h) << 16); }
DEV unsigned pack2(float a, float b) { f32x2 v = {a, b}; hbf2 r = __builtin_convertvector(v, hbf2); return *(unsigned*)&r; }
DEV int ltid() { int t = threadIdx.x; asm volatile("" : "+v"(t)); return t; }
DEV float wave_sum(float v) {
#pragma unroll
  for (int o = 32; o > 0; o >>= 1) v += __shfl_xor(v, o);
  return v;
}
DEV float quad_max(float x) {
  unsigned u = __float_as_uint(x);
  auto r = __builtin_amdgcn_permlane32_swap(u, u, false, false);
  const float a = fmaxf(__uint_as_float(r[0]), __uint_as_float(r[1]));
  const unsigned ua = __float_as_uint(a);
  auto r2 = __builtin_amdgcn_permlane16_swap(ua, ua, false, false);
  return fmaxf(__uint_as_float(r2[0]), __uint_as_float(r2[1]));
}
DEV float quad_sum(float x) {
  unsigned u = __float_as_uint(x);
  auto r = __builtin_amdgcn_permlane32_swap(u, u, false, false);
  const float a = __uint_as_float(r[0]) + __uint_as_float(r[1]);
  const unsigned ua = __float_as_uint(a);
  auto r2 = __builtin_amdgcn_permlane16_swap(ua, ua, false, false);
  return __uint_as_float(r2[0]) + __uint_as_float(r2[1]);
}
struct RowInfo { int b, t, L, mi, tall, sbase; bool ctx; };
DEV RowInfo rowinfo(int row) {
  RowInfo r; r.ctx = row >= NLAT;
  if (r.ctx) { int q = row - NLAT; r.b = q >> 8; r.t = q & 255; r.L = CTX; r.mi = 4; r.tall = r.t; r.sbase = row - r.t; }
  else { r.b = row >> 13; r.t = row & 8191; r.L = SEQ; r.mi = r.b; r.tall = CTX + r.t; r.sbase = row - r.t; }
  return r;
}

DEV int swz4(int x) { return (0x1320 >> (x * 4)) & 3; }
template <int MT, bool SW>
DEV void gemm_mainloop(f32x4 (&acc)[MT][4], const bf16* A, size_t lda, unsigned amask, const bf16* zsrc, const bf16* B, size_t ldb, int K, unsigned char* smem) {
  constexpr int ABYTES = 32 * MT * 64, GST = ABYTES + 8192, NA = MT / 2;
  const int tid = ltid(), lane = tid & 63, wid = tid >> 6, wr = wid >> 1, wc = wid & 1, fr = lane & 15, fq = lane >> 4;
  const int r0 = tid >> 2, gch = (tid & 3) ^ swz4((tid >> 4) & 3);
  const bf16* ga[NA]; int ia[NA];
#pragma unroll
  for (int i = 0; i < NA; ++i) {
    const bool ok = (amask >> i) & 1u;
    ga[i] = ok ? (A + (size_t)(r0 + 64 * i) * lda + gch * 8) : zsrc; ia[i] = ok ? 32 : 0;
  }
  const bf16* gb0 = B + (size_t)r0 * ldb + gch * 8;
  const bf16* gb1 = B + (size_t)(r0 + 64) * ldb + gch * 8;
  unsigned char* ldst = smem + tid * 16;
#define GLDS(stg) do { unsigned char* d_ = ldst + (stg) * GST; \
    _Pragma("unroll") for (int i_ = 0; i_ < NA; ++i_) { __builtin_amdgcn_global_load_lds((const unsigned*)ga[i_], (unsigned*)(d_ + i_ * 4096), 16, 0, 0); ga[i_] += ia[i_]; } \
    __builtin_amdgcn_global_load_lds((const unsigned*)gb0, (unsigned*)(d_ + ABYTES), 16, 0, 0); \
    __builtin_amdgcn_global_load_lds((const unsigned*)gb1, (unsigned*)(d_ + ABYTES + 4096), 16, 0, 0); \
    gb0 += 32; gb1 += 32; } while (0)
  const int rd_a = (wr * 16 * MT + fr) * 64 + ((fq ^ swz4(fr >> 2)) << 4);
  const int rd_b = ABYTES + (wc * 64 + fr) * 64 + ((fq ^ swz4(fr >> 2)) << 4);
  const int nt = K >> 5;
  asm volatile("s_waitcnt vmcnt(0)" ::: "memory");
  GLDS(0);
  if (nt > 1) GLDS(1);
  int st = 0, st2 = 2;
  for (int t = 0; t < nt; ++t) {
    if (t + 1 < nt) { if (MT == 8) asm volatile("s_waitcnt vmcnt(6) lgkmcnt(0)" ::: "memory"); else asm volatile("s_waitcnt vmcnt(4) lgkmcnt(0)" ::: "memory"); }
    else asm volatile("s_waitcnt vmcnt(0) lgkmcnt(0)" ::: "memory");
    __builtin_amdgcn_s_barrier();
    asm volatile("" ::: "memory");
    if (t + 2 < nt) GLDS(st2);
    const unsigned char* s = smem + st * GST;
    bf16x8 bfr[4];
#pragma unroll
    for (int n = 0; n < 4; ++n) bfr[n] = *(const bf16x8*)(s + rd_b + n * 1024);
#pragma unroll
    for (int mh = 0; mh < MT; mh += 4) {
      bf16x8 af[4];
#pragma unroll
      for (int m = 0; m < 4; ++m) af[m] = *(const bf16x8*)(s + rd_a + (mh + m) * 1024);
#pragma unroll
      for (int m = 0; m < 4; ++m)
#pragma unroll
        for (int n = 0; n < 4; ++n)
          acc[mh + m][n] = SW ? __builtin_amdgcn_mfma_f32_16x16x32_bf16(bfr[n], af[m], acc[mh + m][n], 0, 0, 0)
                              : __builtin_amdgcn_mfma_f32_16x16x32_bf16(af[m], bfr[n], acc[mh + m][n], 0, 0, 0);
    }
    st = (st == 2) ? 0 : st + 1; st2 = (st2 == 2) ? 0 : st2 + 1;
  }
#undef GLDS
  __syncthreads();
}

#define TILE_IDS \
  const int tid = ltid(), lane = tid & 63, wid = tid >> 6, wr = wid >> 1, wc = wid & 1, fr = lane & 15, fq = lane >> 4; \
  const int lrow = tid >> 3, lch = tid & 7; (void)lane; (void)wr; (void)wc; (void)fr; (void)fq; (void)lrow; (void)lch;

template <int MT>
DEV void zero_acc(f32x4 (&acc)[MT][4]) {
#pragma unroll
  for (int m = 0; m < MT; ++m)
#pragma unroll
    for (int n = 0; n < 4; ++n) acc[m][n] = f32x4{0.f, 0.f, 0.f, 0.f};
}

template <int MT, bool TR, typename AF>
DEV void epi_store(const f32x4 (&acc)[MT][4], unsigned char* smem, AF addr) {
  const int tid = ltid(), lane = tid & 63, wid = tid >> 6, wr = wid >> 1, wc = wid & 1, fr = lane & 15, fq = lane >> 4;
  constexpr int LD = 136;
  bf16* sC = (bf16*)smem;
#pragma unroll
  for (int m = 0; m < MT; ++m)
#pragma unroll
    for (int n = 0; n < 4; ++n) {
      uint2 o; o.x = pack2(acc[m][n][0], acc[m][n][1]); o.y = pack2(acc[m][n][2], acc[m][n][3]);
      if (TR) *(uint2*)(sC + (wc * 64 + n * 16 + fr) * LD + wr * 64 + m * 16 + fq * 4) = o;
      else *(uint2*)(sC + (wr * 16 * MT + m * 16 + fr) * LD + wc * 64 + n * 16 + fq * 4) = o;
    }
  __syncthreads();
#pragma unroll
  for (int i = 0; i < 2 * MT; ++i) {
    const int idx = tid + 256 * i, r = idx >> 4, ch = idx & 15;
    bf16* g = addr(r, ch);
    if (g) *(uint4*)g = *(const uint4*)(sC + r * LD + ch * 8);
  }
  __syncthreads();
}

DEV void wprep_tile(const float* src, int ld, int nvalid, const float* kscale, bf16* dst, int K, int k0, unsigned char* smem) {
  bf16* sT = (bf16*)smem;
  const int tid = ltid();
  {
    const int nn = tid & 63;
#pragma unroll 4
    for (int i = 0; i < 16; ++i) {
      const int kk = (tid >> 6) + 4 * i;
      float v = 0.f;
      if (nn < nvalid) { v = src[(size_t)(k0 + kk) * ld + nn]; if (kscale) v *= kscale[k0 + kk]; }
      sT[nn * 66 + kk] = f2bf(v);
    }
  }
  __syncthreads();
  {
    const int kk2 = (tid & 31) * 2;
#pragma unroll
    for (int i = 0; i < 8; ++i) {
      const int nn = (tid >> 5) + 8 * i;
      const unsigned v = *(const unsigned*)(sT + nn * 66 + kk2);
      *(unsigned*)(dst + (size_t)nn * K + k0 + kk2) = v;
    }
  }
  __syncthreads();
}

constexpr int WP_TILES_L = 736 + 768 + 96 + 64 + 384 + 256 + 1408 + 704 + 16;
constexpr int MOD_ITEMS = 2 * 96;

DEV void phase_prep(const Params& p, unsigned char* smem) {
  const int tid = ltid();
  const int nitems = 2 * WP_TILES_L + MOD_ITEMS;
  for (int it = blockIdx.x; it < nitems; it += gridDim.x) {
    if (it < MOD_ITEMS) {
      const int l = it / 96, n0 = (it % 96) * 64;
      float* sC = (float*)smem;
      float* sRed = (float*)(smem + 5 * 1024 * 4);
      for (int e = tid; e < 5 * 1024; e += 256) {
        const int v = e >> 10, k = e & 1023;
        const float c = (v < 4) ? p.in[1][v * 1024 + k] : p.in[3][k];
        sC[e] = c / (1.f + __expf(-c));
      }
      __syncthreads();
      const int w = tid >> 6, ln = tid & 63;
      float a[5] = {0.f, 0.f, 0.f, 0.f, 0.f};
      const float* wa = p.in[4] + (size_t)l * 1024 * 6144 + n0 + ln;
      for (int k = w * 256; k < w * 256 + 256; ++k) {
        const float wv = wa[(size_t)k * 6144];
#pragma unroll
        for (int v = 0; v < 5; ++v) a[v] += sC[v * 1024 + k] * wv;
      }
#pragma unroll
      for (int v = 0; v < 5; ++v) sRed[(w * 5 + v) * 64 + ln] = a[v];
      __syncthreads();
      for (int e = tid; e < 5 * 64; e += 256) {
        const int v = e >> 6, nn = e & 63;
        const float s = sRed[(0 * 5 + v) * 64 + nn] + sRed[(1 * 5 + v) * 64 + nn] + sRed[(2 * 5 + v) * 64 + nn] + sRed[(3 * 5 + v) * 64 + nn];
        ((float*)(p.ws + WS_MOD))[(size_t)(l * 5 + v) * 6144 + n0 + nn] = s + p.in[5][l * 6144 + n0 + nn];
      }
      __syncthreads();
    } else {
      int q = it - MOD_ITEMS;
      const int l = q / WP_TILES_L; q -= l * WP_TILES_L;
      unsigned char* wl = p.ws + WS_W + (size_t)l * SZ_WL;
      const float* src; int ld, K, nvalid = 64; const float* ksc = nullptr; bf16* dst; int nc, kc;
      if (q < 736) {
        nc = q / 16; kc = q % 16; K = 1024; ld = INC; src = p.in[10] + (size_t)l * 1024 * INC + nc * 64;
        nvalid = 2848 - nc * 64; dst = (bf16*)(wl + O_WIN) + (size_t)nc * 64 * K;
      } else if ((q -= 736) < 768) {
        nc = q / 16; kc = q % 16; K = 1024; ld = INC; src = p.in[10] + (size_t)l * 1024 * INC + 2848 + nc * 64;
        dst = (bf16*)(wl + O_WG) + (size_t)nc * 64 * K;
      } else if ((q -= 768) < 96) {
        nc = q / 8; kc = q % 8; K = 512; ld = 768; src = p.in[15] + (size_t)l * 512 * 768 + nc * 64; ksc = p.in[14] + l * 512;
        dst = (bf16*)(wl + O_WUQ) + (size_t)nc * 64 * K;
      } else if ((q -= 96) < 64) {
        nc = q / 4; kc = q % 4; K = 256; ld = 1024; ksc = p.in[16] + l * 256;
        src = p.in[17] + (size_t)l * 256 * 1024 + ((nc < 8) ? nc * 128 : (nc - 8) * 128 + 64);
        dst = (bf16*)(wl + O_WUKV) + (size_t)nc * 64 * K;
      } else if ((q -= 64) < 384) {
        const int k3 = q / 128; const int r = q % 128; nc = r / 8; kc = r % 8; K = 512; ld = 1024;
        src = p.in[18] + ((size_t)l * 3 + k3) * 512 * 1024 + nc * 64; dst = (bf16*)(wl + O_WBR) + (size_t)k3 * 1024 * 512 + (size_t)nc * 64 * K;
      } else if ((q -= 384) < 256) {
        nc = q / 16; kc = q % 16; K = 1024; ld = 1024; src = p.in[19] + (size_t)l * 1024 * 1024 + nc * 64; dst = (bf16*)(wl + O_WO) + (size_t)nc * 64 * K;
      } else if ((q -= 256) < 1408) {
        nc = q / 16; kc = q % 16; K = 1024; ld = 2 * DFF;
        const int scol = (nc & 1) ? (DFF + (nc >> 1) * 64) : ((nc >> 1) * 64);
        src = p.in[20] + (size_t)l * 1024 * 2 * DFF + scol; dst = (bf16*)(wl + O_WUP) + (size_t)nc * 64 * K;
      } else if ((q -= 1408) < 704) {
        nc = q / 44; kc = q % 44; K = DFF; ld = 1024; src = p.in[23] + (size_t)l * DFF * 1024 + nc * 64; dst = (bf16*)(wl + O_WDN) + (size_t)nc * 64 * K;
      } else {
        q -= 704; const int g = q >> 2, r = q & 3; nc = r >> 1; kc = r & 1; K = 128; ld = 128;
        src = p.in[12] + ((size_t)l * 4 + g) * 128 * 128 + nc * 64; dst = (bf16*)(wl + O_WPL) + (size_t)g * 128 * 128 + (size_t)nc * 64 * K;
      }
      wprep_tile(src, ld, nvalid, ksc, dst, K, kc * 64, smem);
    }
  }
}

struct RowRegs { float4 x[4]; uint2 y[4]; };
DEV void row_load(RowRegs& r, const float* xin, const bf16* y) {
  const int lane = ltid() & 63;
#pragma unroll
  for (int i = 0; i < 4; ++i) r.x[i] = *(const float4*)(xin + i * 256 + lane * 4);
  if (y) {
#pragma unroll
    for (int i = 0; i < 4; ++i) r.y[i] = *(const uint2*)(y + i * 256 + lane * 4);
  }
}
DEV void row_finish(RowRegs& r, bool has_y, const float* gate, const float* gpost, float* xout,
                    const float* gpre, const float* shift, const float* scale, bf16* hout) {
  const int lane = ltid() & 63;
  float4 (&xv)[4] = r.x;
  if (has_y) {
    float yv[4][4]; float ss = 0.f;
#pragma unroll
    for (int i = 0; i < 4; ++i) {
      const uint2 u = r.y[i];
      yv[i][0] = __uint_as_float(u.x << 16); yv[i][1] = __uint_as_float(u.x & 0xffff0000u);
      yv[i][2] = __uint_as_float(u.y << 16); yv[i][3] = __uint_as_float(u.y & 0xffff0000u);
#pragma unroll
      for (int j = 0; j < 4; ++j) ss += yv[i][j] * yv[i][j];
    }
    ss = wave_sum(ss);
    const float rs = rsqrtf(ss * (1.f / 1024.f) + EPS);
#pragma unroll
    for (int i = 0; i < 4; ++i) {
      const float4 g = *(const float4*)(gate + i * 256 + lane * 4);
      const float4 gp = *(const float4*)(gpost + i * 256 + lane * 4);
      xv[i].x += g.x * (yv[i][0] * rs * gp.x); xv[i].y += g.y * (yv[i][1] * rs * gp.y);
      xv[i].z += g.z * (yv[i][2] * rs * gp.z); xv[i].w += g.w * (yv[i][3] * rs * gp.w);
    }
  }
  if (xout) {
#pragma unroll
    for (int i = 0; i < 4; ++i) *(float4*)(xout + i * 256 + lane * 4) = xv[i];
  }
  if (hout) {
    float ss = 0.f;
#pragma unroll
    for (int i = 0; i < 4; ++i) ss += xv[i].x * xv[i].x + xv[i].y * xv[i].y + xv[i].z * xv[i].z + xv[i].w * xv[i].w;
    ss = wave_sum(ss);
    const float rs = rsqrtf(ss * (1.f / 1024.f) + EPS);
#pragma unroll
    for (int i = 0; i < 4; ++i) {
      const float4 gp = *(const float4*)(gpre + i * 256 + lane * 4);
      const float4 sh = *(const float4*)(shift + i * 256 + lane * 4);
      const float4 sc = *(const float4*)(scale + i * 256 + lane * 4);
      const float h0 = xv[i].x * rs * gp.x * (1.f + sc.x) + sh.x, h1 = xv[i].y * rs * gp.y * (1.f + sc.y) + sh.y;
      const float h2 = xv[i].z * rs * gp.z * (1.f + sc.z) + sh.z, h3 = xv[i].w * rs * gp.w * (1.f + sc.w) + sh.w;
      uint2 o; o.x = pack2(h0, h1); o.y = pack2(h2, h3);
      *(uint2*)(hout + i * 256 + lane * 4) = o;
    }
  }
}

DEV void phase_rows(const Params& p, int l, int kind, int nrows) {
  const int wid = ltid() >> 6;
  const float* MOD = (const float*)(p.ws + WS_MOD);
  float* XC = (float*)(p.ws + WS_XC);
  bf16* H = (bf16*)(p.ws + WS_H);
  const bf16* Y = (const bf16*)(p.ws + WS_Y);
  const int nitems = nrows / 16;
  const bool from_input = (l == 0 && kind <= 1);
  for (int it = blockIdx.x; it < nitems; it += gridDim.x) {
    const int rbase = it * 16 + wid * 4;
    const RowInfo ri = rowinfo(rbase);
    const float* xin0 = ri.ctx ? ((from_input ? p.in[2] : XC) + (size_t)(rbase - NLAT) * D) : ((from_input ? p.in[0] : p.out) + (size_t)rbase * D);
    float* xout0 = ri.ctx ? (XC + (size_t)(rbase - NLAT) * D) : (p.out + (size_t)rbase * D);
    const float* mod = MOD + (size_t)(l * 5 + ri.mi) * 6144;
    const float* mod2 = MOD + (size_t)((l + 1) * 5 + ri.mi) * 6144;
    const bf16* y0 = (kind == 0) ? nullptr : (Y + (size_t)rbase * D);
    bf16* h0 = H + (size_t)rbase * D;
    {
      RowRegs rr[4];
#pragma unroll
      for (int e = 0; e < 4; ++e) row_load(rr[e], xin0 + (size_t)e * D, y0 ? y0 + (size_t)e * D : nullptr);
#pragma unroll
      for (int e = 0; e < 4; ++e) {
        const size_t off = (size_t)e * D;
        if (kind == 0) row_finish(rr[e], false, nullptr, nullptr, nullptr, p.in[6] + l * D, mod, mod + 1024, h0 + off);
        else if (kind == 1) row_finish(rr[e], true, mod + 2048, p.in[7] + l * D, xout0 + off, p.in[8] + l * D, mod + 3072, mod + 4096, h0 + off);
        else row_finish(rr[e], true, mod + 5120, p.in[9] + l * D, xout0 + off, p.in[6] + (l + 1) * D, mod2, mod2 + 1024, (l == 0) ? (h0 + off) : nullptr);
      }
    }
  }
}

DEV void phase_inproj(const Params& p, int l, unsigned char* smem) {
  const int tid = ltid(), lane = tid & 63, wid = tid >> 6, wr = wid >> 1, wc = wid & 1, fr = lane & 15, fq = lane >> 4;
  const bf16* H = (const bf16*)(p.ws + WS_H);
  const bf16* W = (const bf16*)(p.ws + WS_W + (size_t)l * SZ_WL + O_WIN);
  bf16* NAQ = (bf16*)(p.ws + WS_NAQ); bf16* NAK = (bf16*)(p.ws + WS_NAK); bf16* NAVT = (bf16*)(p.ws + WS_NAVT);
  bf16* POOLU = (bf16*)(p.ws + WS_POOLU); bf16* CQ = (bf16*)(p.ws + WS_CQ); bf16* CKV = (bf16*)(p.ws + WS_CKV);
  float* KR = (float*)(p.ws + WS_KR);
  const int nmain = 8 * 2 * 19 * 8, nbig = nmain + 4 * 19, nitems = nbig + 264 * 4;
  for (int it = blockIdx.x; it < nitems; it += gridDim.x) {
    if (it < nbig) {
      int mt, j;
      if (it < nmain) { const int xq = it & 7, jq = it >> 3, ml = jq & 7, jn = jq >> 3; j = jn % 19; mt = ((jn / 19) * 8 + ml) * 8 + xq; }
      else { const int q = it - nmain; mt = 128 + q / 19; j = q % 19; }
      const int ntile = (j < 8) ? j : j + 4, row0 = mt * 256, n0 = ntile * 128;
      f32x4 acc[8][4]; zero_acc<8>(acc);
      gemm_mainloop<8, true>(acc, H + (size_t)row0 * D, D, 15u, nullptr, W + (size_t)n0 * 1024, 1024, 1024, smem);
      if (ntile == 22) {
#pragma unroll
        for (int m = 0; m < 8; ++m)
#pragma unroll
          for (int n = 0; n < 4; ++n) {
            const int col = wc * 64 + n * 16 + fq * 4, row = row0 + wr * 128 + m * 16 + fr;
            if (col < 32) *(float4*)(KR + (size_t)row * 32 + col) = make_float4(acc[m][n][0], acc[m][n][1], acc[m][n][2], acc[m][n][3]);
          }
        __syncthreads();
      } else {
        bf16* dst; int ld, c0 = n0 & 511;
        if (ntile < 4) {
          dst = NAQ; ld = 512;
          const float sc = 0.125f * 1.4426950408889634f;
#pragma unroll
          for (int m = 0; m < 8; ++m)
#pragma unroll
            for (int n = 0; n < 4; ++n) acc[m][n] *= sc;
        } else if (ntile < 8) { dst = NAK; ld = 512; }
        else if (ntile < 16) { dst = POOLU; ld = 512; }
        else if (ntile < 20) { dst = CQ; ld = 512; }
        else { dst = CKV; ld = 256; c0 = n0 - 2560; }
        bf16* db = dst + (size_t)row0 * ld + c0;
        epi_store<8, false>(acc, smem, [=](int r, int ch) -> bf16* { return db + (size_t)r * ld + ch * 8; });
      }
    } else {
      const int q = it - nbig, mt = q >> 2, ntile = 8 + (q & 3), row0 = mt * 128, n0 = ntile * 128;
      const RowInfo r0 = rowinfo(row0);
      f32x4 acc[4][4]; zero_acc<4>(acc);
      gemm_mainloop<4, false>(acc, H + (size_t)row0 * D, D, 3u, nullptr, W + (size_t)n0 * 1024, 1024, 1024, smem);
      const int c0 = n0 - 1024;
      bf16* vb = NAVT + (size_t)r0.b * 8 * 64 * TALL + r0.tall;
      epi_store<4, true>(acc, smem, [=](int cl, int ch) -> bf16* { return vb + (size_t)(c0 + cl) * TALL + ch * 8; });
    }
  }
}

DEV float rope_inv(int f) {
  const float tb[8] = {1.f, 0.316227766f, 0.1f, 0.0316227766f, 0.01f, 0.00316227766f, 0.001f, 0.000316227766f};
  float r = tb[0];
#pragma unroll
  for (int i = 1; i < 8; ++i) r = (f == i) ? tb[i] : r;
  return r;
}

template <int HW>
DEV void pool_diff16(const bf16* ub, bf16* db, int t0, int L) {
  constexpr int NR = 16 + 2 * HW - 1;
  float v0[NR], v1[NR];
#pragma unroll
  for (int i = 0; i < NR; ++i) {
    const int t = t0 - HW + i;
    const bool ok = (t >= 0) && (t < L);
    const unsigned u = *(const unsigned*)(ub + (size_t)(ok ? t : t0) * 512);
    v0[i] = ok ? __uint_as_float(u << 16) : 0.f; v1[i] = ok ? __uint_as_float(u & 0xffff0000u) : 0.f;
  }
#pragma unroll
  for (int rr = 0; rr < 16; ++rr) {
    float s0 = 0.f, s1 = 0.f;
#pragma unroll
    for (int k = 0; k < 2 * HW; ++k) { s0 += v0[rr + k]; s1 += v1[rr + k]; }
    const int t = t0 + rr;
    const float inv = 1.f / (float)(min(t + HW, L) - max(t - HW, 0));
    *(unsigned*)(db + (size_t)rr * 512) = pack2(s0 * inv - v0[rr + HW], s1 * inv - v1[rr + HW]);
  }
}

DEV void phase_mlaproj(const Params& p, int l, unsigned char* smem) {
  TILE_IDS
  const bf16* CQ = (const bf16*)(p.ws + WS_CQ); const bf16* CKV = (const bf16*)(p.ws + WS_CKV);
  const float* KR = (const float*)(p.ws + WS_KR);
  const bf16* POOLU = (const bf16*)(p.ws + WS_POOLU); bf16* POOLD = (bf16*)(p.ws + WS_POOLD);
  bf16* QF = (bf16*)(p.ws + WS_QF); bf16* KF = (bf16*)(p.ws + WS_KF); bf16* VT = (bf16*)(p.ws + WS_VT);
  const bf16* WUQ = (const bf16*)(p.ws + WS_W + (size_t)l * SZ_WL + O_WUQ);
  const bf16* WUKV = (const bf16*)(p.ws + WS_W + (size_t)l * SZ_WL + O_WUKV);
  float* sR = (float*)(smem + LDS_GEMM);
  constexpr int N_UQ = 264 * 6, N_UKV = 264 * 8, N_ROPE = 264, N_PD = MT / 16;
  const int nitems = N_UQ + N_UKV + N_ROPE + N_PD;
  const float QSCALE = 0.10206207261596575f * 1.4426950408889634f;
  for (int it = blockIdx.x; it < nitems; it += gridDim.x) {
    if (it < N_UQ + N_UKV) {
      const bool isq = it < N_UQ;
      const int q = isq ? it : it - N_UQ;
      const int xq = q & 7, jq = q >> 3;
      const int mt = (isq ? jq / 6 : jq >> 3) * 8 + xq, ntile = isq ? jq % 6 : jq & 7, row0 = mt * 128, n0 = ntile * 128;
      const int KD = isq ? 512 : 256;
      const bf16* A = isq ? CQ : CKV; const bf16* W = isq ? WUQ : WUKV;
      {
        const int rl = tid >> 1, half = tid & 1;
        const bf16* rp = A + (size_t)(row0 + rl) * KD + half * (KD / 2);
        float ss = 0.f;
        for (int i = 0; i < KD / 16; ++i) {
          const uint4 v = *(const uint4*)(rp + i * 8);
          const unsigned uu[4] = {v.x, v.y, v.z, v.w};
#pragma unroll
          for (int e = 0; e < 4; ++e) { const float a = __uint_as_float(uu[e] << 16), b = __uint_as_float(uu[e] & 0xffff0000u); ss += a * a + b * b; }
        }
        ss += __shfl_xor(ss, 1);
        if (!half) sR[rl] = rsqrtf(ss / (float)KD + EPS);
      }
      f32x4 acc[4][4]; zero_acc<4>(acc);
      const bf16* a0 = A + (size_t)row0 * KD;
      const bf16* b0 = W + (size_t)n0 * KD;
      const RowInfo r0 = rowinfo(row0);
      if (isq) {
        gemm_mainloop<4, true>(acc, a0, KD, 3u, nullptr, b0, KD, KD, smem);
#pragma unroll
        for (int m = 0; m < 4; ++m) {
          const int rl = wr * 64 + m * 16 + fr, t = r0.t + rl;
          const float rs = sR[rl] * QSCALE;
#pragma unroll
          for (int n = 0; n < 4; ++n) {
            const int colb = n0 + wc * 64 + n * 16;
            const int h = colb / 96, cb = colb - h * 96;
#pragma unroll
            for (int j = 0; j < 4; ++j) {
              float v = acc[m][n][j] * rs;
              const float pv = __shfl_xor(v, 32);
              if (cb >= 64 && !r0.ctx) {
                const int hf = (cb - 64) >> 4, ii = fq * 4 + j, f = ii & 7;
                const float pos = (float)(hf ? (t & 63) : (t >> 6));
                float sn, cs; __sincosf(pos * rope_inv(f), &sn, &cs);
                v = (ii >> 3) ? (pv * sn + v * cs) : (v * cs - pv * sn);
              }
              acc[m][n][j] = v;
            }
          }
        }
        bf16* db = QF + (size_t)row0 * 768 + n0;
        epi_store<4, false>(acc, smem, [=](int r, int ch) -> bf16* { return db + (size_t)r * 768 + ch * 8; });
      } else if (ntile < 4) {
        gemm_mainloop<4, true>(acc, a0, KD, 3u, nullptr, b0, KD, KD, smem);
#pragma unroll
        for (int m = 0; m < 4; ++m) {
          const float rs = sR[wr * 64 + m * 16 + fr];
#pragma unroll
          for (int n = 0; n < 4; ++n) acc[m][n] *= rs;
        }
        bf16* kb = KF + ((size_t)(r0.b * 8 + 2 * ntile) * TALL + r0.tall) * 96;
        epi_store<4, false>(acc, smem, [=](int r, int ch) -> bf16* { return kb + ((size_t)(ch >> 3) * TALL + r) * 96 + (ch & 7) * 8; });
      } else {
        gemm_mainloop<4, false>(acc, a0, KD, 3u, nullptr, b0, KD, KD, smem);
#pragma unroll
        for (int m = 0; m < 4; ++m)
#pragma unroll
          for (int j = 0; j < 4; ++j) {
            const float rs = sR[wr * 64 + m * 16 + fq * 4 + j];
#pragma unroll
            for (int n = 0; n < 4; ++n) acc[m][n][j] *= rs;
          }
        bf16* vb = VT + (size_t)(r0.b * 8 + 2 * (ntile - 4)) * 64 * TALL + r0.tall;
        epi_store<4, true>(acc, smem, [=](int cl, int ch) -> bf16* { return vb + (size_t)cl * TALL + ch * 8; });
      }
    } else if (it < N_UQ + N_UKV + N_ROPE) {
      const int row0 = (it - N_UQ - N_UKV) * 128;
      for (int e = tid; e < 128 * 16; e += 256) {
        const int rl = e >> 4, pp = e & 15, hf = pp >> 3, f = pp & 7, row = row0 + rl;
        const RowInfo ri = rowinfo(row);
        const float x1 = KR[(size_t)row * 32 + hf * 16 + f], x2 = KR[(size_t)row * 32 + hf * 16 + 8 + f];
        float o1 = x1, o2 = x2;
        if (!ri.ctx) {
          const float pos = (float)(hf ? (ri.t & 63) : (ri.t >> 6));
          float sn, cs; __sincosf(pos * rope_inv(f), &sn, &cs);
          o1 = x1 * cs - x2 * sn; o2 = x1 * sn + x2 * cs;
        }
        const bf16 b1 = f2bf(o1), b2 = f2bf(o2);
#pragma unroll
        for (int h = 0; h < 8; ++h) {
          bf16* kd = KF + ((size_t)(ri.b * 8 + h) * TALL + ri.tall) * 96 + 64 + hf * 16 + f;
          kd[0] = b1; kd[8] = b2;
        }
      }
    } else {
      const int row0 = (it - N_UQ - N_UKV - N_ROPE) * 16;
      const int ch = tid * 2, g = ch >> 7;
      const RowInfo r0 = rowinfo(row0);
      const bf16* ub = POOLU + (size_t)r0.sbase * 512 + ch;
      bf16* db = POOLD + (size_t)row0 * 512 + ch;
      if (g == 0) pool_diff16<1>(ub, db, r0.t, r0.L);
      else if (g == 1) pool_diff16<2>(ub, db, r0.t, r0.L);
      else if (g == 2) pool_diff16<4>(ub, db, r0.t, r0.L);
      else pool_diff16<8>(ub, db, r0.t, r0.L);
    }
  }
}

struct FlashDesc {
  const bf16* q; int qstride;
  bf16* o; int ostride;
  const bf16* kwin; const bf16* kseq; int kstride;
  const bf16* vbase;
  int nwin, r0a, nchunks;
  int qr0;
  const float* rpb;
};

template <int DQK>
DEV void flash_unit(const FlashDesc& fd, unsigned char* smem) {
  constexpr int NKP = DQK / 32, KBYTES = NKP * 4096, STAGE = KBYTES + 8192, NKS = DQK / 32;
  const int tid = ltid(), lane = tid & 63, w = tid >> 6, fr = lane & 15, fq = lane >> 4;
  float* sRpb = (float*)(smem + 3 * STAGE);
  if (fd.nwin > 0) { for (int e = tid; e < 465; e += 256) sRpb[e] = fd.rpb[e] * 1.4426950408889634f; }
  bf16x8 qf[2][NKS];
#pragma unroll
  for (int nt = 0; nt < 2; ++nt)
#pragma unroll
    for (int ks = 0; ks < NKS; ++ks) qf[nt][ks] = *(const bf16x8*)(fd.q + (size_t)(w * 32 + nt * 16 + fr) * fd.qstride + ks * 32 + fq * 8);
  f32x4 O[4][2];
#pragma unroll
  for (int m = 0; m < 4; ++m) { O[m][0] = f32x4{0.f, 0.f, 0.f, 0.f}; O[m][1] = f32x4{0.f, 0.f, 0.f, 0.f}; }
  float mrun[2] = {0.f, 0.f};
  f32x4 Lacc[2] = {f32x4{0.f, 0.f, 0.f, 0.f}, f32x4{0.f, 0.f, 0.f, 0.f}};
  bf16x8 ones; { union { uint4 u; bf16x8 b; } cv; cv.u = make_uint4(0x3F803F80u, 0x3F803F80u, 0x3F803F80u, 0x3F803F80u); ones = cv.b; }
  bool first = true;
  const int srow = tid >> 2, sch = (tid & 3) ^ swz4((tid >> 4) & 3);
  const int skey = ((srow >> 5) * 32) + (((srow >> 2) & 3) * 8) + (((srow >> 4) & 1) * 4) + (srow & 3);
  const size_t koff = (size_t)skey * fd.kstride + sch * 8, voff = (size_t)srow * TALL + sch * 8;
  unsigned char* ldst = smem + tid * 16;
#define F_GLDS(c_, stg_) do { const int c__ = (c_); const bf16* kp; const bf16* vp; \
    if (c__ < fd.nwin) { const int kr = fd.r0a + c__; kp = fd.kwin + (size_t)kr * 64 * fd.kstride; vp = fd.vbase + CTX + kr * 64; } \
    else { const int cc = c__ - fd.nwin; kp = fd.kseq + (size_t)cc * 64 * fd.kstride; vp = fd.vbase + cc * 64; } \
    unsigned char* d_ = ldst + (stg_) * STAGE; \
    _Pragma("unroll") for (int p_ = 0; p_ < NKP; ++p_) __builtin_amdgcn_global_load_lds((const unsigned*)(kp + koff + p_ * 32), (unsigned*)(d_ + p_ * 4096), 16, 0, 0); \
    __builtin_amdgcn_global_load_lds((const unsigned*)(vp + voff), (unsigned*)(d_ + KBYTES), 16, 0, 0); \
    __builtin_amdgcn_global_load_lds((const unsigned*)(vp + voff + 32), (unsigned*)(d_ + KBYTES + 4096), 16, 0, 0); } while (0)
  const int rdo = fr * 64 + ((fq ^ swz4(fr >> 2)) << 4);
  const int nch = fd.nchunks;
  const int qr = fd.qr0 + (w >> 1);
  const int r0q = min(max(qr - 4, 0), 120);
  asm volatile("s_waitcnt vmcnt(0)" ::: "memory");
  F_GLDS(0, 0);
  if (nch > 1) F_GLDS(1, 1);
  int st = 0, st2 = 2;
  for (int c = 0; c < nch; ++c) {
    if (c + 1 < nch) { if (DQK == 96) asm volatile("s_waitcnt vmcnt(5) lgkmcnt(0)" ::: "memory"); else asm volatile("s_waitcnt vmcnt(4) lgkmcnt(0)" ::: "memory"); }
    else asm volatile("s_waitcnt vmcnt(0) lgkmcnt(0)" ::: "memory");
    __builtin_amdgcn_s_barrier();
    asm volatile("" ::: "memory");
    if (c + 2 < nch) F_GLDS(c + 2, st2);
    const unsigned char* s = smem + st * STAGE;
    st = (st == 2) ? 0 : st + 1; st2 = (st2 == 2) ? 0 : st2 + 1;
    const bool iswin = c < fd.nwin;
    const int keyrow = fd.r0a + c;
    const bool active = !iswin || (keyrow >= r0q && keyrow < r0q + 8);
    if (active) {
      f32x4 S[4][2];
      {
        const float c0 = first ? 0.f : -mrun[0], c1 = first ? 0.f : -mrun[1];
        const f32x4 ci0 = f32x4{c0, c0, c0, c0}, ci1 = f32x4{c1, c1, c1, c1};
        bf16x8 kf[4][NKS];
#pragma unroll
        for (int m = 0; m < 4; ++m)
#pragma unroll
          for (int ks = 0; ks < NKS; ++ks) kf[m][ks] = *(const bf16x8*)(s + ks * 4096 + m * 1024 + rdo);
#pragma unroll
        for (int m = 0; m < 4; ++m)
#pragma unroll
          for (int ks = 0; ks < NKS; ++ks) {
            S[m][0] = __builtin_amdgcn_mfma_f32_16x16x32_bf16(kf[m][ks], qf[0][ks], ks == 0 ? ci0 : S[m][0], 0, 0, 0);
            S[m][1] = __builtin_amdgcn_mfma_f32_16x16x32_bf16(kf[m][ks], qf[1][ks], ks == 0 ? ci1 : S[m][1], 0, 0, 0);
          }
      }
      bf16x8 vf[4][2];
#pragma unroll
      for (int m = 0; m < 4; ++m)
#pragma unroll
        for (int k2 = 0; k2 < 2; ++k2) {
          vf[m][k2] = *(const bf16x8*)(s + KBYTES + k2 * 4096 + m * 1024 + rdo);
        }
      if (iswin) {
        const float* brow = sRpb + (keyrow - qr + 7) * 31;
#pragma unroll
        for (int nt = 0; nt < 2; ++nt) {
          const int qc = (w & 1) * 32 + nt * 16 + fr;
          const int win0 = min(max(qc - 8, 0), 48);
#pragma unroll
          for (int m = 0; m < 4; ++m) {
            float bv[4];
#pragma unroll
            for (int j = 0; j < 4; ++j) bv[j] = brow[min(max((m >> 1) * 32 + fq * 8 + (m & 1) * 4 + j - qc + 15, 0), 30)];
#pragma unroll
            for (int j = 0; j < 4; ++j) {
              const int kc = (m >> 1) * 32 + fq * 8 + (m & 1) * 4 + j;
              const float sv = S[m][nt][j] + bv[j];
              S[m][nt][j] = ((kc >= win0) && (kc < win0 + 16)) ? sv : -1e30f;
            }
          }
        }
      }
      bf16x8 pf[2][2];
#pragma unroll
      for (int nt = 0; nt < 2; ++nt) {
        float mx = __builtin_fmaxf(__builtin_fmaxf(S[0][nt][0], S[0][nt][1]), S[0][nt][2]);
        mx = __builtin_fmaxf(__builtin_fmaxf(mx, S[0][nt][3]), S[1][nt][0]);
        mx = __builtin_fmaxf(__builtin_fmaxf(mx, S[1][nt][1]), S[1][nt][2]);
        mx = __builtin_fmaxf(__builtin_fmaxf(mx, S[1][nt][3]), S[2][nt][0]);
        mx = __builtin_fmaxf(__builtin_fmaxf(mx, S[2][nt][1]), S[2][nt][2]);
        mx = __builtin_fmaxf(__builtin_fmaxf(mx, S[2][nt][3]), S[3][nt][0]);
        mx = __builtin_fmaxf(__builtin_fmaxf(mx, S[3][nt][1]), S[3][nt][2]);
        mx = __builtin_fmaxf(mx, S[3][nt][3]);
        mx = quad_max(mx);
        if (first || __ballot(mx > 8.f) != 0ull) {
          const float dm = first ? mx : fmaxf(mx, 0.f);
          const float alpha = __builtin_amdgcn_exp2f(-dm);
          mrun[nt] += dm; Lacc[nt] *= alpha;
#pragma unroll
          for (int m = 0; m < 4; ++m) { O[m][nt] *= alpha; S[m][nt] -= dm; }
        }
        unsigned pu[4][2];
#pragma unroll
        for (int m = 0; m < 4; ++m) {
          const float e0 = __builtin_amdgcn_exp2f(S[m][nt][0]), e1 = __builtin_amdgcn_exp2f(S[m][nt][1]);
          const float e2 = __builtin_amdgcn_exp2f(S[m][nt][2]), e3 = __builtin_amdgcn_exp2f(S[m][nt][3]);
          pu[m][0] = pack2(e0, e1); pu[m][1] = pack2(e2, e3);
        }
#pragma unroll
        for (int k2 = 0; k2 < 2; ++k2) {
          union { uint4 u; bf16x8 b; } cv; cv.u = make_uint4(pu[2 * k2][0], pu[2 * k2][1], pu[2 * k2 + 1][0], pu[2 * k2 + 1][1]);
          pf[nt][k2] = cv.b;
        }
      }
#pragma unroll
      for (int m = 0; m < 4; ++m)
#pragma unroll
        for (int k2 = 0; k2 < 2; ++k2) {
          O[m][0] = __builtin_amdgcn_mfma_f32_16x16x32_bf16(vf[m][k2], pf[0][k2], O[m][0], 0, 0, 0);
          O[m][1] = __builtin_amdgcn_mfma_f32_16x16x32_bf16(vf[m][k2], pf[1][k2], O[m][1], 0, 0, 0);
        }
#pragma unroll
      for (int k2 = 0; k2 < 2; ++k2) {
        Lacc[0] = __builtin_amdgcn_mfma_f32_16x16x32_bf16(ones, pf[0][k2], Lacc[0], 0, 0, 0);
        Lacc[1] = __builtin_amdgcn_mfma_f32_16x16x32_bf16(ones, pf[1][k2], Lacc[1], 0, 0, 0);
      }
      first = false;
    }
  }
#pragma unroll
  for (int nt = 0; nt < 2; ++nt) {
    const float lt = Lacc[nt][0];
    const float il = 1.f / lt;
    bf16* op = fd.o + (size_t)(w * 32 + nt * 16 + fr) * fd.ostride + fq * 4;
#pragma unroll
    for (int m = 0; m < 4; ++m) {
      uint2 o; o.x = pack2(O[m][nt][0] * il, O[m][nt][1] * il); o.y = pack2(O[m][nt][2] * il, O[m][nt][3] * il);
      *(uint2*)(op + m * 16) = o;
    }
  }
  __syncthreads();
}

#ifndef MIXONLY
#define MIXONLY -1
#endif
#define MIXON(k) (MIXONLY == -1 || MIXONLY == (k))
DEV void phase_mixers(const Params& p, int l, unsigned char* smem) {
  TILE_IDS
  bf16* NAQ = (bf16*)(p.ws + WS_NAQ); const bf16* NAK = (const bf16*)(p.ws + WS_NAK); const bf16* NAVT = (const bf16*)(p.ws + WS_NAVT);
  const bf16* POOLD = (const bf16*)(p.ws + WS_POOLD); bf16* OPOOL = (bf16*)(p.ws + WS_POOLU); bf16* OMLA = (bf16*)(p.ws + WS_CQ);
  const bf16* QF = (const bf16*)(p.ws + WS_QF);
  const bf16* KF = (const bf16*)(p.ws + WS_KF); const bf16* VT = (const bf16*)(p.ws + WS_VT);
  const bf16* WPL = (const bf16*)(p.ws + WS_W + (size_t)l * SZ_WL + O_WPL);
  constexpr int N_MLA = 2048, N_NA = 2048;
  const int n_ctx = (l == 0) ? 128 : 0;
  const int n_flash = N_MLA + N_NA + n_ctx;
  const int n_pool = (l == 0 ? 264 : 256) * 4;
  const int nitems = n_flash + n_pool;
  for (int it = blockIdx.x; it < nitems; it += gridDim.x) {
    if (it < n_flash) {
      FlashDesc fd; fd.nwin = 0; fd.r0a = 0; fd.qr0 = 0; fd.rpb = nullptr; fd.kwin = nullptr; fd.ostride = 512;
      bool is96;
      if (it < N_MLA) {
        const int x = it & 7, slot = it >> 3, pair = (slot >> 6) * 8 + x, qb = slot & 63, b = pair >> 3, h = pair & 7;
        is96 = true;
        fd.q = QF + (size_t)(b * SEQ + qb * 128) * 768 + h * 96; fd.qstride = 768;
        fd.o = OMLA + (size_t)(b * SEQ + qb * 128) * 512 + h * 64;
        fd.kseq = KF + (size_t)pair * TALL * 96; fd.kstride = 96; fd.vbase = VT + (size_t)pair * 64 * TALL;
        fd.nchunks = TALL / 64;
      } else if (it < N_MLA + N_NA) {
        const int q = it - N_MLA, xq = q & 7, slot = q >> 3, pair = (slot >> 6) * 8 + xq, rp = slot & 63, b = pair >> 3, h = pair & 7, r = rp * 2;
        const int r0a = min(max(r - 4, 0), 120), r0b = min(max(r - 3, 0), 120);
        is96 = false;
        fd.q = NAQ + (size_t)(b * SEQ + r * 64) * 512 + h * 64; fd.qstride = 512; fd.o = NAQ + (size_t)(b * SEQ + r * 64) * 512 + h * 64;
        fd.kwin = NAK + (size_t)(b * SEQ) * 512 + h * 64; fd.kseq = NAK + (size_t)(NLAT + b * CTX) * 512 + h * 64; fd.kstride = 512;
        fd.vbase = NAVT + (size_t)pair * 64 * TALL;
        fd.nwin = r0b + 8 - r0a; fd.r0a = r0a; fd.nchunks = fd.nwin + 4; fd.qr0 = r;
        fd.rpb = p.in[11] + ((size_t)l * 8 + h) * 465;
      } else {
        const int q = it - N_MLA - N_NA;
        const int kind = q >> 6, u = q & 63, pair = u >> 1, qb = u & 1, b = pair >> 3, h = pair & 7;
        fd.nchunks = 4;
        if (kind == 0) {
          is96 = false;
          fd.q = NAQ + (size_t)(NLAT + b * CTX + qb * 128) * 512 + h * 64; fd.qstride = 512; fd.o = NAQ + (size_t)(NLAT + b * CTX + qb * 128) * 512 + h * 64;
          fd.kseq = NAK + (size_t)(NLAT + b * CTX) * 512 + h * 64; fd.kstride = 512; fd.vbase = NAVT + (size_t)pair * 64 * TALL;
        } else {
          is96 = true;
          fd.q = QF + (size_t)(NLAT + b * CTX + qb * 128) * 768 + h * 96; fd.qstride = 768; fd.o = OMLA + (size_t)(NLAT + b * CTX + qb * 128) * 512 + h * 64;
          fd.kseq = KF + (size_t)pair * TALL * 96; fd.kstride = 96; fd.vbase = VT + (size_t)pair * 64 * TALL;
        }
      }
      if (is96) flash_unit<96>(fd, smem); else flash_unit<64>(fd, smem);
    } else {
      const int q = it - n_flash, mt = q >> 2, g = q & 3, row0 = mt * 128;
      f32x4 acc[4][4]; zero_acc<4>(acc);
      gemm_mainloop<4, true>(acc, POOLD + (size_t)row0 * 512 + g * 128, 512, 3u, nullptr, WPL + (size_t)g * 128 * 128, 128, 128, smem);
      const float* psc = p.in[13] + l * 512 + g * 128;
#pragma unroll
      for (int n = 0; n < 4; ++n) {
        const float4 sc = *(const float4*)(psc + wc * 64 + n * 16 + fq * 4);
#pragma unroll
        for (int m = 0; m < 4; ++m) { acc[m][n][0] *= sc.x; acc[m][n][1] *= sc.y; acc[m][n][2] *= sc.z; acc[m][n][3] *= sc.w; }
      }
      bf16* db = OPOOL + (size_t)row0 * 512 + g * 128;
      epi_store<4, false>(acc, smem, [=](int r, int ch) -> bf16* { return db + (size_t)r * 512 + ch * 8; });
    }
  }
}

DEV void phase_merge(const Params& p, int l, int mtiles, unsigned char* smem) {
  TILE_IDS
  const bf16* H = (const bf16*)(p.ws + WS_H);
  const bf16* WG = (const bf16*)(p.ws + WS_W + (size_t)l * SZ_WL + O_WG);
  bf16* GATED = (bf16*)(p.ws + WS_GATED);
  const int nitems = mtiles * 8;
  for (int it = blockIdx.x; it < nitems; it += gridDim.x) {
    const int xq = it & 7, jq = it >> 3, mt = (jq >> 3) * 8 + xq, ntile = jq & 7, row0 = mt * 128, n0 = ntile * 128;
    f32x4 gsum[4][4]; zero_acc<4>(gsum);
#pragma unroll 1
    for (int k = 0; k < 3; ++k) {
      f32x4 ag[4][4]; zero_acc<4>(ag);
      gemm_mainloop<4, true>(ag, H + (size_t)row0 * D, D, 3u, nullptr, WG + (size_t)(k * 1024 + n0) * 1024, 1024, 1024, smem);
      const bf16* pb = (const bf16*)(p.ws + ((k == 0) ? WS_PB0 : ((k == 1) ? WS_PB1 : WS_PB2))) + (size_t)row0 * D + n0;
#pragma unroll
      for (int m = 0; m < 4; ++m)
#pragma unroll
        for (int n = 0; n < 4; ++n) {
          const uint2 u = *(const uint2*)(pb + (size_t)(wr * 64 + m * 16 + fr) * D + wc * 64 + n * 16 + fq * 4);
          const float p0 = __uint_as_float(u.x << 16), p1 = __uint_as_float(u.x & 0xffff0000u), p2 = __uint_as_float(u.y << 16), p3 = __uint_as_float(u.y & 0xffff0000u);
          gsum[m][n][0] += p0 * __builtin_amdgcn_rcpf(1.f + __expf(-ag[m][n][0])); gsum[m][n][1] += p1 * __builtin_amdgcn_rcpf(1.f + __expf(-ag[m][n][1]));
          gsum[m][n][2] += p2 * __builtin_amdgcn_rcpf(1.f + __expf(-ag[m][n][2])); gsum[m][n][3] += p3 * __builtin_amdgcn_rcpf(1.f + __expf(-ag[m][n][3]));
        }
    }
    bf16* db = GATED + (size_t)row0 * D + n0;
    epi_store<4, false>(gsum, smem, [=](int r, int ch) -> bf16* { return db + (size_t)r * D + ch * 8; });
  }
}

DEV void phase_gemm_out(const Params& p, const bf16* A, int lda, int K, const bf16* W, bf16* OUT, int mtiles, unsigned char* smem, int ngroups) {
  const int nbig = 128 * 8, per = nbig + (mtiles - 256) * 8, nitems = per * ngroups;
  for (int it = blockIdx.x; it < nitems; it += gridDim.x) {
    const int g = it / per, q = it - g * per;
    const bf16* Ag = A; const bf16* Wg = W; bf16* Og = OUT;
    if (ngroups == 3) {
      Ag = (const bf16*)(p.ws + ((g == 0) ? WS_NAQ : ((g == 1) ? WS_POOLU : WS_CQ)));
      Wg = W + (size_t)g * 1024 * 512;
      Og = (bf16*)(p.ws + ((g == 0) ? WS_PB0 : ((g == 1) ? WS_PB1 : WS_PB2)));
    }
    if (q < nbig) {
      const int xq = q & 7, jq = q >> 3, row0 = ((jq >> 3) * 8 + xq) * 256, n0 = (jq & 7) * 128;
      f32x4 acc[8][4]; zero_acc<8>(acc);
      gemm_mainloop<8, true>(acc, Ag + (size_t)row0 * lda, lda, 15u, nullptr, Wg + (size_t)n0 * K, K, K, smem);
      bf16* db = Og + (size_t)row0 * D + n0;
      epi_store<8, false>(acc, smem, [=](int r, int ch) -> bf16* { return db + (size_t)r * D + ch * 8; });
    } else {
      const int q2 = q - nbig, row0 = NLAT + (q2 >> 3) * 128, n0 = (q2 & 7) * 128;
      f32x4 acc[4][4]; zero_acc<4>(acc);
      gemm_mainloop<4, true>(acc, Ag + (size_t)row0 * lda, lda, 3u, nullptr, Wg + (size_t)n0 * K, K, K, smem);
      bf16* db = Og + (size_t)row0 * D + n0;
      epi_store<4, false>(acc, smem, [=](int r, int ch) -> bf16* { return db + (size_t)r * D + ch * 8; });
    }
  }
}

DEV void phase_ffn_up(const Params& p, int l, unsigned char* smem) {
  const int tid = ltid(), lane = tid & 63, wid = tid >> 6, wr = wid >> 1, wc = wid & 1, fr = lane & 15, fq = lane >> 4;
  const bf16* H = (const bf16*)(p.ws + WS_H);
  const bf16* WUP = (const bf16*)(p.ws + WS_W + (size_t)l * SZ_WL + O_WUP);
  bf16* ACT = (bf16*)(p.ws + WS_ACT);
  const float* cw = p.in[21] + (size_t)l * 3 * 2 * DFF; const float* cb = p.in[22] + (size_t)l * 2 * DFF;
  const int nmain = 8 * 2 * 44 * 8, nbig = nmain + 4 * 44;
  const int nitems = nbig + ((l == 0) ? 8 * 44 : 0);
  bf16* U = (bf16*)smem;
  for (int it = blockIdx.x; it < nitems; it += gridDim.x) {
    int sbase, L, ti, ntile;
    if (it < nbig) {
      int mi;
      if (it < nmain) { const int xq = it & 7, jq = it >> 3, ml = jq & 7, jn = jq >> 3; ntile = jn % 44; mi = ((jn / 44) * 8 + ml) * 8 + xq; }
      else { const int q = it - nmain; mi = 128 + q / 44; ntile = q % 44; }
      const int b = mi / 33; ti = mi % 33; sbase = b * SEQ; L = SEQ;
    } else { const int q2 = it - nbig, q = q2 / 44; ntile = q2 % 44; const int b = q >> 1; ti = q & 1; sbase = NLAT + b * CTX; L = CTX; }
    const int t0 = ti * 254;
    unsigned amask = 0;
#pragma unroll
    for (int i = 0; i < 4; ++i) { const int t = t0 - 1 + (tid >> 2) + 64 * i; amask |= (t >= 0 && t < L) ? (1u << i) : 0u; }
    f32x4 acc[8][4]; zero_acc<8>(acc);
    gemm_mainloop<8, true>(acc, H + ((ptrdiff_t)(sbase + t0 - 1)) * D, D, amask, (const bf16*)(p.ws + WS_BAR), WUP + (size_t)(ntile * 128) * 1024, 1024, 1024, smem);
#pragma unroll
    for (int m = 0; m < 8; ++m)
#pragma unroll
      for (int n = 0; n < 4; ++n) {
        uint2 o; o.x = pack2(acc[m][n][0], acc[m][n][1]); o.y = pack2(acc[m][n][2], acc[m][n][3]);
        *(uint2*)(U + (wr * 128 + m * 16 + fr) * 136 + wc * 64 + n * 16 + fq * 4) = o;
      }
    __syncthreads();
    {
      const int cq = (tid & 15) * 4, rg = tid >> 4, ca = ntile * 64 + cq, cbi = DFF + ca;
      const float4 wa0 = *(const float4*)(cw + ca), wa1 = *(const float4*)(cw + 2 * DFF + ca), wa2 = *(const float4*)(cw + 4 * DFF + ca), ba = *(const float4*)(cb + ca);
      const float4 wb0 = *(const float4*)(cw + cbi), wb1 = *(const float4*)(cw + 2 * DFF + cbi), wb2 = *(const float4*)(cw + 4 * DFF + cbi), bb = *(const float4*)(cb + cbi);
#define LD4(dst, ptr) { const uint2 u_ = *(const uint2*)(ptr); dst = make_float4(__uint_as_float(u_.x << 16), __uint_as_float(u_.x & 0xffff0000u), __uint_as_float(u_.y << 16), __uint_as_float(u_.y & 0xffff0000u)); }
      const int lr0 = rg * 16;
      float4 a0, a1, a2, b0, b1, b2;
      LD4(a0, U + max(lr0 - 1, 0) * 136 + cq) LD4(b0, U + max(lr0 - 1, 0) * 136 + 64 + cq)
      LD4(a1, U + lr0 * 136 + cq) LD4(b1, U + lr0 * 136 + 64 + cq)
      const float GC = -1.5957691216057308f * 1.4426950408889634f;
#pragma unroll 4
      for (int q = 0; q < 16; ++q) {
        const int lr = lr0 + q, t = t0 - 1 + lr;
        LD4(a2, U + min(lr + 1, 255) * 136 + cq) LD4(b2, U + min(lr + 1, 255) * 136 + 64 + cq)
        if (lr >= 1 && lr <= 254 && t < L) {
          float o[4];
#define CONV1(X) { const float av = fmaf(wa2.X, a2.X, fmaf(wa1.X, a1.X, fmaf(wa0.X, a0.X, ba.X))); const float bv = fmaf(wb2.X, b2.X, fmaf(wb1.X, b1.X, fmaf(wb0.X, b0.X, bb.X))); \
            const float u_ = av * fmaf(av * av, 0.044715f, 1.f); ov = av * bv * __builtin_amdgcn_rcpf(1.f + __builtin_amdgcn_exp2f(GC * u_)); }
          float ov;
          CONV1(x) o[0] = ov; CONV1(y) o[1] = ov; CONV1(z) o[2] = ov; CONV1(w) o[3] = ov;
#undef CONV1
          uint2 pk; pk.x = pack2(o[0], o[1]); pk.y = pack2(o[2], o[3]);
          *(uint2*)(ACT + (size_t)(sbase + t) * DFF + ca) = pk;
        }
        a0 = a1; a1 = a2; b0 = b1; b1 = b2;
      }
#undef LD4
    }
    __syncthreads();
  }
}

#define XB_TMO      128
#define XB_XCNT(j)  (256  + 64 * (j))
#define XB_XSUB(j)  (1280 + 64 * (j))
#define XB_XGEN(j)  (2304 + 64 * (j))
#define XB_TOP      3328
#define XB_TOPGEN   3392
#define XCD_BAR_WORDS 3456
#define XB_SPIN_CAP (1u << 18)
#define LAS __attribute__((address_space(3)))
DEV unsigned xb_ld(unsigned* p)              { return __hip_atomic_load(p, __ATOMIC_RELAXED, __HIP_MEMORY_SCOPE_AGENT); }
DEV unsigned xb_add(unsigned* p, unsigned v) { return __hip_atomic_fetch_add(p, v, __ATOMIC_RELAXED, __HIP_MEMORY_SCOPE_AGENT); }
DEV unsigned xb_xcc_id() { return (unsigned)__builtin_amdgcn_s_getreg((3 << 11) | 20) & 0xFu; }
#define XB_SPIN(cond, bar) do { unsigned _sp = 0; while (cond) { __builtin_amdgcn_s_sleep(1); \
    if ((++_sp & 255u) == 0u) { if (xb_ld(&(bar)[XB_TMO])) break; if (_sp > XB_SPIN_CAP) { atomicAdd(&(bar)[XB_TMO], 1u); break; } } } } while (0)
struct XcdBarrier { unsigned* bar; unsigned x; volatile LAS unsigned* st; };
DEV XcdBarrier xcd_barrier_post(unsigned* bar, volatile LAS unsigned* st) {
  XcdBarrier b; b.bar = bar; b.x = xb_xcc_id(); b.st = st;
  if (threadIdx.x == 0) (void)xb_add(&bar[XB_XCNT(b.x)], 1u);
  return b;
}
DEV void xcd_barrier_complete(unsigned* bar, unsigned x, unsigned& nloc, unsigned& nx) {
  const unsigned G = gridDim.x * gridDim.y * gridDim.z;
  unsigned sum, cnt, mine, sp = 0u;
  for (;;) {
    sum = 0u; cnt = 0u; mine = 0u;
#pragma unroll
    for (unsigned j = 0; j < 16; ++j) { const unsigned c = xb_ld(&bar[XB_XCNT(j)]); sum += c; cnt += (c > 0u) ? 1u : 0u; mine = (j == x) ? c : mine; }
    if (sum == G) break;
    __builtin_amdgcn_s_sleep(1);
    if ((++sp & 255u) == 0u) { if (xb_ld(&bar[XB_TMO])) break; if (sp > XB_SPIN_CAP) { atomicAdd(&bar[XB_TMO], 1u); break; } }
  }
  nloc = mine > 0u ? mine : 1u; nx = cnt > 0u ? cnt : 1u;
}
DEV void xcd_barrier(const XcdBarrier& b) {
  asm volatile("s_waitcnt vmcnt(0)" ::: "memory");
  __syncthreads();
  if (threadIdx.x == 0) {
    unsigned* bar = b.bar;
    __builtin_amdgcn_s_waitcnt(0);
    unsigned nloc = b.st[0], nx = b.st[1];
    if (nloc == 0u) { xcd_barrier_complete(bar, b.x, nloc, nx); b.st[0] = nloc; b.st[1] = nx; }
    const unsigned old = xb_add(&bar[XB_XSUB(b.x)], 1u);
    const unsigned gen = old / nloc;
    if (old + 1u == (gen + 1u) * nloc) {
      __builtin_amdgcn_fence(__ATOMIC_RELEASE, "agent");
      asm volatile("s_waitcnt vmcnt(0)" ::: "memory");
      const unsigned og = xb_add(&bar[XB_TOP], 1u);
      const unsigned tg = og / nx;
      if (og + 1u == (tg + 1u) * nx) xb_add(&bar[XB_TOPGEN], 1u);
      else XB_SPIN(xb_ld(&bar[XB_TOPGEN]) == tg, bar);
      __builtin_amdgcn_fence(__ATOMIC_ACQUIRE, "agent");
      xb_add(&bar[XB_XGEN(b.x)], 1u);
      asm volatile("s_waitcnt vmcnt(0)" ::: "memory");
    } else {
      XB_SPIN(xb_ld(&bar[XB_XGEN(b.x)]) == gen, bar);
      __builtin_amdgcn_fence(__ATOMIC_ACQUIRE, "agent");
      asm volatile("s_waitcnt vmcnt(0)" ::: "memory");
    }
  }
  __syncthreads();
}

constexpr int N_PHASES = 22;
DEV void run_phase(const Params& pin, int ph, unsigned char* smem) {
  Params p = pin;
  {
    size_t z = 0; asm volatile("" : "+s"(z));
    p.ws = pin.ws + z; p.out = pin.out + z;
  }
  if (ph == 0) { phase_prep(p, smem); return; }
  if (ph == 1) { phase_rows(p, 0, 0, MT); return; }
  const int l = (ph - 2) / 10, s = (ph - 2) % 10;
  const int mtiles = (l == 0) ? 264 : 256;
  const unsigned char* wl = p.ws + WS_W + (size_t)l * SZ_WL;
  switch (s) {
    case 0: phase_inproj(p, l, smem); break;
    case 1: phase_mlaproj(p, l, smem); break;
    case 2: phase_mixers(p, l, smem); break;
    case 3: phase_gemm_out(p, (const bf16*)(p.ws + WS_NAQ), 512, 512, (const bf16*)(wl + O_WBR), (bf16*)(p.ws + WS_PB0), mtiles, smem, 3); break;
    case 4: phase_merge(p, l, mtiles, smem); break;
    case 5: phase_gemm_out(p, (const bf16*)(p.ws + WS_GATED), D, D, (const bf16*)(wl + O_WO), (bf16*)(p.ws + WS_Y), mtiles, smem, 1); break;
    case 6: phase_rows(p, l, 1, mtiles * 128); break;
    case 7: phase_ffn_up(p, l, smem); break;
    case 8: phase_gemm_out(p, (const bf16*)(p.ws + WS_ACT), DFF, DFF, (const bf16*)(wl + O_WDN), (bf16*)(p.ws + WS_Y), mtiles, smem, 1); break;
    case 9: phase_rows(p, l, 2, mtiles * 128); break;
  }
}

__global__ void __launch_bounds__(256, 2) mega(Params p) {
  extern __shared__ __attribute__((aligned(16))) unsigned char smem[];
  volatile LAS unsigned* st = (volatile LAS unsigned*)(smem + LDS_GEMM + 1024);
  if (threadIdx.x == 0) { st[0] = 0u; st[1] = 0u; }
  __syncthreads();
  XcdBarrier xb;
  if (p.ph_hi - p.ph_lo > 1) xb = xcd_barrier_post((unsigned*)(p.ws + WS_BAR), st);
  for (int ph = p.ph_lo; ph < p.ph_hi; ++ph) {
    if (ph > p.ph_lo) {
      if (p.ph_hi > N_PHASES) cg::this_grid().sync();
      else xcd_barrier(xb);
    }
    run_phase(p, ph, smem);
  }
}

extern "C" void kernel_launch(void* const* d_in, const int* in_sizes, int n_in, void* d_out, int out_size, void* d_ws, size_t ws_size, hipStream_t stream) {
  static int grid = 0;
  if (grid == 0) {
    if (n_in != 24 || ws_size < WS_TOTAL) { fprintf(stderr, "kernel_launch: need 24 inputs and %zu bytes of workspace (got %d, %zu)\n", (size_t)WS_TOTAL, n_in, ws_size); grid = -1; return; }
    int dev = 0, cus = 0, per_cu = 0;
    hipGetDevice(&dev);
    hipDeviceGetAttribute(&cus, hipDeviceAttributeMultiprocessorCount, dev);
    if (hipFuncSetAttribute((const void*)mega, hipFuncAttributeMaxDynamicSharedMemorySize, LDS_BYTES) != hipSuccess) { fprintf(stderr, "hipFuncSetAttribute failed\n"); grid = -1; return; }
    if (hipOccupancyMaxActiveBlocksPerMultiprocessor(&per_cu, (const void*)mega, 256, LDS_BYTES) != hipSuccess || per_cu < 1) per_cu = 1;
    if (per_cu > 2) per_cu = 2;
    grid = cus * per_cu;
  }
  if (grid < 0) return;
  Params p{};
  for (int i = 0; i < 24; ++i) p.in[i] = (const float*)d_in[i];
  p.out = (float*)d_out; p.ws = (unsigned char*)d_ws;
#if ONE_LAUNCH
  if (hipMemsetAsync((unsigned char*)d_ws + WS_BAR, 0, XCD_BAR_WORDS * 4, stream) != hipSuccess) { fprintf(stderr, "barrier memset failed\n"); return; }
  p.ph_lo = 0; p.ph_hi = N_PHASES;
  void* args[] = {&p};
  hipError_t e = hipLaunchCooperativeKernel((const void*)mega, dim3(grid), dim3(256), args, LDS_BYTES, stream);
  if (e != hipSuccess) fprintf(stderr, "cooperative launch failed: %s (grid %d)\n", hipGetErrorString(e), grid);
#else
  for (int ph = 0; ph < N_PHASES; ++ph) {
    p.ph_lo = ph; p.ph_hi = ph + 1;
    hipLaunchKernelGGL(mega, dim3(grid), dim3(256), LDS_BYTES, stream, p);
  }
#endif
}
```

```cpp
#include <hip/hip_runtime.h>
#include <hip/hip_cooperative_groups.h>
#include <cstdio>
#include <cstdint>
namespace cg = cooperative_groups;

#ifndef ONE_LAUNCH
#define ONE_LAUNCH 1
#endif

typedef unsigned short bf16;
typedef __attribute__((ext_vector_type(8))) short bf16x8;
typedef __attribute__((ext_vector_type(4))) float f32x4;
#define DEV __device__ __forceinline__

constexpr int D = 1024, NB = 4, SEQ = 8192, CTX = 256;
constexpr int NLAT = NB * SEQ, NCTX = NB * CTX, MT = NLAT + NCTX;
constexpr int TALL = CTX + SEQ;
constexpr int INC = 5920, DFF = 2816;
constexpr float EPS = 1e-6f;

constexpr size_t SZ_WIN = (size_t)2944 * 1024 * 2, SZ_WG = (size_t)3072 * 1024 * 2, SZ_WUQ = (size_t)768 * 512 * 2,
                 SZ_WUKV = (size_t)1024 * 256 * 2, SZ_WBR = (size_t)3 * 1024 * 512 * 2, SZ_WO = (size_t)1024 * 1024 * 2,
                 SZ_WUP = (size_t)5632 * 1024 * 2, SZ_WDN = (size_t)1024 * 2816 * 2, SZ_WPL = (size_t)4 * 128 * 128 * 2;
constexpr size_t O_WIN = 0, O_WG = O_WIN + SZ_WIN, O_WUQ = O_WG + SZ_WG, O_WUKV = O_WUQ + SZ_WUQ, O_WBR = O_WUKV + SZ_WUKV,
                 O_WO = O_WBR + SZ_WBR, O_WUP = O_WO + SZ_WO, O_WDN = O_WUP + SZ_WUP, O_WPL = O_WDN + SZ_WDN, SZ_WL = O_WPL + SZ_WPL;
constexpr size_t WS_W = 0;
constexpr size_t WS_MOD = WS_W + 2 * SZ_WL;
constexpr size_t WS_XC = WS_MOD + 2 * 5 * 6144 * 4;
constexpr size_t WS_H = WS_XC + (size_t)NCTX * D * 4;
constexpr size_t SZ_R512 = (size_t)MT * 512 * 2;
constexpr size_t WS_A = WS_H + (size_t)MT * D * 2;
constexpr size_t WS_POOLU = WS_A;
constexpr size_t WS_CQ = WS_POOLU + SZ_R512;
constexpr size_t WS_CKV = WS_CQ + SZ_R512;
constexpr size_t WS_KR = WS_CKV + (size_t)MT * 256 * 2;
constexpr size_t WS_B = WS_KR + (size_t)MT * 32 * 4;
constexpr size_t WS_POOLD = WS_B;
constexpr size_t WS_QF = WS_POOLD + SZ_R512;
constexpr size_t WS_KF = WS_QF + (size_t)MT * 768 * 2;
constexpr size_t WS_VT = WS_KF + (size_t)NB * 8 * TALL * 96 * 2;
constexpr size_t WS_C = WS_VT + (size_t)NB * 8 * 64 * TALL * 2;
constexpr size_t WS_NAQ = WS_C;
constexpr size_t WS_NAK = WS_NAQ + SZ_R512;
constexpr size_t WS_NAVT = WS_NAK + SZ_R512;
constexpr size_t WS_END = WS_NAVT + (size_t)NB * 8 * 64 * TALL * 2;
constexpr size_t WS_GATED = WS_B;
constexpr size_t WS_Y = WS_C;
constexpr size_t WS_ACT = WS_A;
constexpr size_t WS_PB0 = WS_GATED, WS_PB1 = WS_GATED + (size_t)MT * D * 2, WS_PB2 = WS_NAK;
static_assert(WS_PB1 + (size_t)MT * D * 2 <= WS_C, "branch projections overflow region B");
constexpr size_t WS_BAR = (WS_END + 255) & ~(size_t)255;
constexpr size_t WS_TOTAL = WS_BAR + 3456 * 4;
static_assert(WS_ACT + (size_t)MT * DFF * 2 <= WS_C, "ACT overlaps Y");
static_assert(WS_GATED + (size_t)MT * D * 2 <= WS_KF, "GATED too big");

constexpr int LDS_GEMM = 73728;
constexpr int LDS_BYTES = LDS_GEMM + 2048;

struct Params {
  const float* in[24];
  float* out;
  unsigned char* ws;
  int ph_lo, ph_hi;
};

typedef __bf16 hbf2 __attribute__((ext_vector_type(2)));
typedef float f32x2 __attribute__((ext_vector_type(2)));
DEV bf16 f2bf(float f) { __bf16 h = (__bf16)f; return *(bf16*)&h; }
DEV float bf2f(bf16 h) { return __uint_as_float(((unsigned)h) << 16); }
DEV unsigned pack2(float a, float b) { f32x2 v = {a, b}; hbf2 r = __builtin_convertvector(v, hbf2); return *(unsigned*)&r; }
DEV int ltid() { int t = threadIdx.x; asm volatile("" : "+v"(t)); return t; }
DEV float wave_sum(float v) {
#pragma unroll
  for (int o = 32; o > 0; o >>= 1) v += __shfl_xor(v, o);
  return v;
}
DEV float quad_max(float x) {
  unsigned u = __float_as_uint(x);
  auto r = __builtin_amdgcn_permlane32_swap(u, u, false, false);
  const float a = fmaxf(__uint_as_float(r[0]), __uint_as_float(r[1]));
  const unsigned ua = __float_as_uint(a);
  auto r2 = __builtin_amdgcn_permlane16_swap(ua, ua, false, false);
  return fmaxf(__uint_as_float(r2[0]), __uint_as_float(r2[1]));
}
DEV float quad_sum(float x) {
  unsigned u = __float_as_uint(x);
  auto r = __builtin_amdgcn_permlane32_swap(u, u, false, false);
  const float a = __uint_as_float(r[0]) + __uint_as_float(r[1]);
  const unsigned ua = __float_as_uint(a);
  auto r2 = __builtin_amdgcn_permlane16_swap(ua, ua, false, false);
  return __uint_as_float(r2[0]) + __uint_as_float(r2[1]);
}
struct RowInfo { int b, t, L, mi, tall, sbase; bool ctx; };
DEV RowInfo rowinfo(int row) {
  RowInfo r; r.ctx = row >= NLAT;
  if (r.ctx) { int q = row - NLAT; r.b = q >> 8; r.t = q & 255; r.L = CTX; r.mi = 4; r.tall = r.t; r.sbase = row - r.t; }
  else { r.b = row >> 13; r.t = row & 8191; r.L = SEQ; r.mi = r.b; r.tall = CTX + r.t; r.sbase = row - r.t; }
  return r;
}

DEV int swz4(int x) { return (0x1320 >> (x * 4)) & 3; }
template <int MT, bool SW>
DEV void gemm_mainloop(f32x4 (&acc)[MT][4], const bf16* A, size_t lda, unsigned amask, const bf16* zsrc, const bf16* B, size_t ldb, int K, unsigned char* smem) {
  constexpr int ABYTES = 32 * MT * 64, GST = ABYTES + 8192, NA = MT / 2;
  const int tid = ltid(), lane = tid & 63, wid = tid >> 6, wr = wid >> 1, wc = wid & 1, fr = lane & 15, fq = lane >> 4;
  const int r0 = tid >> 2, gch = (tid & 3) ^ swz4((tid >> 4) & 3);
  const bf16* ga[NA]; int ia[NA];
#pragma unroll
  for (int i = 0; i < NA; ++i) {
    const bool ok = (amask >> i) & 1u;
    ga[i] = ok ? (A + (size_t)(r0 + 64 * i) * lda + gch * 8) : zsrc; ia[i] = ok ? 32 : 0;
  }
  const bf16* gb0 = B + (size_t)r0 * ldb + gch * 8;
  const bf16* gb1 = B + (size_t)(r0 + 64) * ldb + gch * 8;
  unsigned char* ldst = smem + tid * 16;
#define GLDS(stg) do { unsigned char* d_ = ldst + (stg) * GST; \
    _Pragma("unroll") for (int i_ = 0; i_ < NA; ++i_) { __builtin_amdgcn_global_load_lds((const unsigned*)ga[i_], (unsigned*)(d_ + i_ * 4096), 16, 0, 0); ga[i_] += ia[i_]; } \
    __builtin_amdgcn_global_load_lds((const unsigned*)gb0, (unsigned*)(d_ + ABYTES), 16, 0, 0); \
    __builtin_amdgcn_global_load_lds((const unsigned*)gb1, (unsigned*)(d_ + ABYTES + 4096), 16, 0, 0); \
    gb0 += 32; gb1 += 32; } while (0)
  const int rd_a = (wr * 16 * MT + fr) * 64 + ((fq ^ swz4(fr >> 2)) << 4);
  const int rd_b = ABYTES + (wc * 64 + fr) * 64 + ((fq ^ swz4(fr >> 2)) << 4);
  const int nt = K >> 5;
  asm volatile("s_waitcnt vmcnt(0)" ::: "memory");
  GLDS(0);
  if (nt > 1) GLDS(1);
  int st = 0, st2 = 2;
  for (int t = 0; t < nt; ++t) {
    if (t + 1 < nt) { if (MT == 8) asm volatile("s_waitcnt vmcnt(6) lgkmcnt(0)" ::: "memory"); else asm volatile("s_waitcnt vmcnt(4) lgkmcnt(0)" ::: "memory"); }
    else asm volatile("s_waitcnt vmcnt(0) lgkmcnt(0)" ::: "memory");
    __builtin_amdgcn_s_barrier();
    asm volatile("" ::: "memory");
    if (t + 2 < nt) GLDS(st2);
    const unsigned char* s = smem + st * GST;
    bf16x8 bfr[4];
#pragma unroll
    for (int n = 0; n < 4; ++n) bfr[n] = *(const bf16x8*)(s + rd_b + n * 1024);
#pragma unroll
    for (int mh = 0; mh < MT; mh += 4) {
      bf16x8 af[4];
#pragma unroll
      for (int m = 0; m < 4; ++m) af[m] = *(const bf16x8*)(s + rd_a + (mh + m) * 1024);
#pragma unroll
      for (int m = 0; m < 4; ++m)
#pragma unroll
        for (int n = 0; n < 4; ++n)
          acc[mh + m][n] = SW ? __builtin_amdgcn_mfma_f32_16x16x32_bf16(bfr[n], af[m], acc[mh + m][n], 0, 0, 0)
                              : __builtin_amdgcn_mfma_f32_16x16x32_bf16(af[m], bfr[n], acc[mh + m][n], 0, 0, 0);
    }
    st = (st == 2) ? 0 : st + 1; st2 = (st2 == 2) ? 0 : st2 + 1;
  }
#undef GLDS
  __syncthreads();
}

#define TILE_IDS \
  const int tid = ltid(), lane = tid & 63, wid = tid >> 6, wr = wid >> 1, wc = wid & 1, fr = lane & 15, fq = lane >> 4; \
  const int lrow = tid >> 3, lch = tid & 7; (void)lane; (void)wr; (void)wc; (void)fr; (void)fq; (void)lrow; (void)lch;

template <int MT>
DEV void zero_acc(f32x4 (&acc)[MT][4]) {
#pragma unroll
  for (int m = 0; m < MT; ++m)
#pragma unroll
    for (int n = 0; n < 4; ++n) acc[m][n] = f32x4{0.f, 0.f, 0.f, 0.f};
}

template <int MT, bool TR, typename AF>
DEV void epi_store(const f32x4 (&acc)[MT][4], unsigned char* smem, AF addr) {
  const int tid = ltid(), lane = tid & 63, wid = tid >> 6, wr = wid >> 1, wc = wid & 1, fr = lane & 15, fq = lane >> 4;
  constexpr int LD = 136;
  bf16* sC = (bf16*)smem;
#pragma unroll
  for (int m = 0; m < MT; ++m)
#pragma unroll
    for (int n = 0; n < 4; ++n) {
      uint2 o; o.x = pack2(acc[m][n][0], acc[m][n][1]); o.y = pack2(acc[m][n][2], acc[m][n][3]);
      if (TR) *(uint2*)(sC + (wc * 64 + n * 16 + fr) * LD + wr * 64 + m * 16 + fq * 4) = o;
      else *(uint2*)(sC + (wr * 16 * MT + m * 16 + fr) * LD + wc * 64 + n * 16 + fq * 4) = o;
    }
  __syncthreads();
#pragma unroll
  for (int i = 0; i < 2 * MT; ++i) {
    const int idx = tid + 256 * i, r = idx >> 4, ch = idx & 15;
    bf16* g = addr(r, ch);
    if (g) *(uint4*)g = *(const uint4*)(sC + r * LD + ch * 8);
  }
  __syncthreads();
}

DEV void wprep_tile(const float* src, int ld, int nvalid, const float* kscale, bf16* dst, int K, int k0, unsigned char* smem) {
  bf16* sT = (bf16*)smem;
  const int tid = ltid();
  {
    const int nn = (tid & 15) * 4;
#pragma unroll
    for (int i = 0; i < 4; ++i) {
      const int kk = (tid >> 4) + 16 * i;
      float4 v = make_float4(0.f, 0.f, 0.f, 0.f);
      if (nn < nvalid) v = *(const float4*)(src + (size_t)(k0 + kk) * ld + nn);
      if (kscale) { const float ks = kscale[k0 + kk]; v.x *= ks; v.y *= ks; v.z *= ks; v.w *= ks; }
      sT[(nn + 0) * 66 + kk] = f2bf(v.x); sT[(nn + 1) * 66 + kk] = f2bf(v.y);
      sT[(nn + 2) * 66 + kk] = f2bf(v.z); sT[(nn + 3) * 66 + kk] = f2bf(v.w);
    }
  }
  __syncthreads();
  {
    const int kk2 = (tid & 31) * 2;
#pragma unroll
    for (int i = 0; i < 8; ++i) {
      const int nn = (tid >> 5) + 8 * i;
      const unsigned v = *(const unsigned*)(sT + nn * 66 + kk2);
      *(unsigned*)(dst + (size_t)nn * K + k0 + kk2) = v;
    }
  }
  __syncthreads();
}

constexpr int WP_TILES_L = 736 + 768 + 96 + 64 + 384 + 256 + 1408 + 704 + 16;
constexpr int MOD_ITEMS = 2 * 96;

DEV void phase_prep(const Params& p, unsigned char* smem) {
  const int tid = ltid();
  const int nitems = 2 * WP_TILES_L + MOD_ITEMS;
  for (int it = blockIdx.x; it < nitems; it += gridDim.x) {
    if (it < MOD_ITEMS) {
      const int l = it / 96, n0 = (it % 96) * 64;
      float* sC = (float*)smem;
      float* sRed = (float*)(smem + 5 * 1024 * 4);
      for (int e = tid; e < 5 * 1024; e += 256) {
        const int v = e >> 10, k = e & 1023;
        const float c = (v < 4) ? p.in[1][v * 1024 + k] : p.in[3][k];
        sC[e] = c / (1.f + __expf(-c));
      }
      __syncthreads();
      const int w = tid >> 6, ln = tid & 63;
      float a[5] = {0.f, 0.f, 0.f, 0.f, 0.f};
      const float* wa = p.in[4] + (size_t)l * 1024 * 6144 + n0 + ln;
      for (int k = w * 256; k < w * 256 + 256; ++k) {
        const float wv = wa[(size_t)k * 6144];
#pragma unroll
        for (int v = 0; v < 5; ++v) a[v] += sC[v * 1024 + k] * wv;
      }
#pragma unroll
      for (int v = 0; v < 5; ++v) sRed[(w * 5 + v) * 64 + ln] = a[v];
      __syncthreads();
      for (int e = tid; e < 5 * 64; e += 256) {
        const int v = e >> 6, nn = e & 63;
        const float s = sRed[(0 * 5 + v) * 64 + nn] + sRed[(1 * 5 + v) * 64 + nn] + sRed[(2 * 5 + v) * 64 + nn] + sRed[(3 * 5 + v) * 64 + nn];
        ((float*)(p.ws + WS_MOD))[(size_t)(l * 5 + v) * 6144 + n0 + nn] = s + p.in[5][l * 6144 + n0 + nn];
      }
      __syncthreads();
    } else {
      int q = it - MOD_ITEMS;
      const int l = q / WP_TILES_L; q -= l * WP_TILES_L;
      unsigned char* wl = p.ws + WS_W + (size_t)l * SZ_WL;
      const float* src; int ld, K, nvalid = 64; const float* ksc = nullptr; bf16* dst; int nc, kc;
      if (q < 736) {
        nc = q / 16; kc = q % 16; K = 1024; ld = INC; src = p.in[10] + (size_t)l * 1024 * INC + nc * 64;
        nvalid = 2848 - nc * 64; dst = (bf16*)(wl + O_WIN) + (size_t)nc * 64 * K;
      } else if ((q -= 736) < 768) {
        nc = q / 16; kc = q % 16; K = 1024; ld = INC; src = p.in[10] + (size_t)l * 1024 * INC + 2848 + nc * 64;
        dst = (bf16*)(wl + O_WG) + (size_t)nc * 64 * K;
      } else if ((q -= 768) < 96) {
        nc = q / 8; kc = q % 8; K = 512; ld = 768; src = p.in[15] + (size_t)l * 512 * 768 + nc * 64; ksc = p.in[14] + l * 512;
        dst = (bf16*)(wl + O_WUQ) + (size_t)nc * 64 * K;
      } else if ((q -= 96) < 64) {
        nc = q / 4; kc = q % 4; K = 256; ld = 1024; ksc = p.in[16] + l * 256;
        src = p.in[17] + (size_t)l * 256 * 1024 + ((nc < 8) ? nc * 128 : (nc - 8) * 128 + 64);
        dst = (bf16*)(wl + O_WUKV) + (size_t)nc * 64 * K;
      } else if ((q -= 64) < 384) {
        const int k3 = q / 128; const int r = q % 128; nc = r / 8; kc = r % 8; K = 512; ld = 1024;
        src = p.in[18] + ((size_t)l * 3 + k3) * 512 * 1024 + nc * 64; dst = (bf16*)(wl + O_WBR) + (size_t)k3 * 1024 * 512 + (size_t)nc * 64 * K;
      } else if ((q -= 384) < 256) {
        nc = q / 16; kc = q % 16; K = 1024; ld = 1024; src = p.in[19] + (size_t)l * 1024 * 1024 + nc * 64; dst = (bf16*)(wl + O_WO) + (size_t)nc * 64 * K;
      } else if ((q -= 256) < 1408) {
        nc = q / 16; kc = q % 16; K = 1024; ld = 2 * DFF;
        const int scol = (nc & 1) ? (DFF + (nc >> 1) * 64) : ((nc >> 1) * 64);
        src = p.in[20] + (size_t)l * 1024 * 2 * DFF + scol; dst = (bf16*)(wl + O_WUP) + (size_t)nc * 64 * K;
      } else if ((q -= 1408) < 704) {
        nc = q / 44; kc = q % 44; K = DFF; ld = 1024; src = p.in[23] + (size_t)l * DFF * 1024 + nc * 64; dst = (bf16*)(wl + O_WDN) + (size_t)nc * 64 * K;
      } else {
        q -= 704; const int g = q >> 2, r = q & 3; nc = r >> 1; kc = r & 1; K = 128; ld = 128;
        src = p.in[12] + ((size_t)l * 4 + g) * 128 * 128 + nc * 64; dst = (bf16*)(wl + O_WPL) + (size_t)g * 128 * 128 + (size_t)nc * 64 * K;
      }
      wprep_tile(src, ld, nvalid, ksc, dst, K, kc * 64, smem);
    }
  }
}

struct RowRegs { float4 x[4]; uint2 y[4]; };
DEV void row_load(RowRegs& r, const float* xin, const bf16* y) {
  const int lane = ltid() & 63;
#pragma unroll
  for (int i = 0; i < 4; ++i) r.x[i] = *(const float4*)(xin + i * 256 + lane * 4);
  if (y) {
#pragma unroll
    for (int i = 0; i < 4; ++i) r.y[i] = *(const uint2*)(y + i * 256 + lane * 4);
  }
}
DEV void row_finish(RowRegs& r, bool has_y, const float* gate, const float* gpost, float* xout,
                    const float* gpre, const float* shift, const float* scale, bf16* hout) {
  const int lane = ltid() & 63;
  float4 (&xv)[4] = r.x;
  if (has_y) {
    float yv[4][4]; float ss = 0.f;
#pragma unroll
    for (int i = 0; i < 4; ++i) {
      const uint2 u = r.y[i];
      yv[i][0] = __uint_as_float(u.x << 16); yv[i][1] = __uint_as_float(u.x & 0xffff0000u);
      yv[i][2] = __uint_as_float(u.y << 16); yv[i][3] = __uint_as_float(u.y & 0xffff0000u);
#pragma unroll
      for (int j = 0; j < 4; ++j) ss += yv[i][j] * yv[i][j];
    }
    ss = wave_sum(ss);
    const float rs = rsqrtf(ss * (1.f / 1024.f) + EPS);
#pragma unroll
    for (int i = 0; i < 4; ++i) {
      const float4 g = *(const float4*)(gate + i * 256 + lane * 4);
      const float4 gp = *(const float4*)(gpost + i * 256 + lane * 4);
      xv[i].x += g.x * (yv[i][0] * rs * gp.x); xv[i].y += g.y * (yv[i][1] * rs * gp.y);
      xv[i].z += g.z * (yv[i][2] * rs * gp.z); xv[i].w += g.w * (yv[i][3] * rs * gp.w);
    }
  }
  if (xout) {
#pragma unroll
    for (int i = 0; i < 4; ++i) *(float4*)(xout + i * 256 + lane * 4) = xv[i];
  }
  if (hout) {
    float ss = 0.f;
#pragma unroll
    for (int i = 0; i < 4; ++i) ss += xv[i].x * xv[i].x + xv[i].y * xv[i].y + xv[i].z * xv[i].z + xv[i].w * xv[i].w;
    ss = wave_sum(ss);
    const float rs = rsqrtf(ss * (1.f / 1024.f) + EPS);
#pragma unroll
    for (int i = 0; i < 4; ++i) {
      const float4 gp = *(const float4*)(gpre + i * 256 + lane * 4);
      const float4 sh = *(const float4*)(shift + i * 256 + lane * 4);
      const float4 sc = *(const float4*)(scale + i * 256 + lane * 4);
      const float h0 = xv[i].x * rs * gp.x * (1.f + sc.x) + sh.x, h1 = xv[i].y * rs * gp.y * (1.f + sc.y) + sh.y;
      const float h2 = xv[i].z * rs * gp.z * (1.f + sc.z) + sh.z, h3 = xv[i].w * rs * gp.w * (1.f + sc.w) + sh.w;
      uint2 o; o.x = pack2(h0, h1); o.y = pack2(h2, h3);
      *(uint2*)(hout + i * 256 + lane * 4) = o;
    }
  }
}

DEV void phase_rows(const Params& p, int l, int kind, int nrows) {
  const int wid = ltid() >> 6;
  const float* MOD = (const float*)(p.ws + WS_MOD);
  float* XC = (float*)(p.ws + WS_XC);
  bf16* H = (bf16*)(p.ws + WS_H);
  const bf16* Y = (const bf16*)(p.ws + WS_Y);
  const int nitems = nrows / 16;
  const bool from_input = (l == 0 && kind <= 1);
  for (int it = blockIdx.x; it < nitems; it += gridDim.x) {
    const int rbase = it * 16 + wid * 4;
    const RowInfo ri = rowinfo(rbase);
    const float* xin0 = ri.ctx ? ((from_input ? p.in[2] : XC) + (size_t)(rbase - NLAT) * D) : ((from_input ? p.in[0] : p.out) + (size_t)rbase * D);
    float* xout0 = ri.ctx ? (XC + (size_t)(rbase - NLAT) * D) : (p.out + (size_t)rbase * D);
    const float* mod = MOD + (size_t)(l * 5 + ri.mi) * 6144;
    const float* mod2 = MOD + (size_t)((l + 1) * 5 + ri.mi) * 6144;
    const bf16* y0 = (kind == 0) ? nullptr : (Y + (size_t)rbase * D);
    bf16* h0 = H + (size_t)rbase * D;
    {
      RowRegs rr[4];
#pragma unroll
      for (int e = 0; e < 4; ++e) row_load(rr[e], xin0 + (size_t)e * D, y0 ? y0 + (size_t)e * D : nullptr);
#pragma unroll
      for (int e = 0; e < 4; ++e) {
        const size_t off = (size_t)e * D;
        if (kind == 0) row_finish(rr[e], false, nullptr, nullptr, nullptr, p.in[6] + l * D, mod, mod + 1024, h0 + off);
        else if (kind == 1) row_finish(rr[e], true, mod + 2048, p.in[7] + l * D, xout0 + off, p.in[8] + l * D, mod + 3072, mod + 4096, h0 + off);
        else row_finish(rr[e], true, mod + 5120, p.in[9] + l * D, xout0 + off, p.in[6] + (l + 1) * D, mod2, mod2 + 1024, (l == 0) ? (h0 + off) : nullptr);
      }
    }
  }
}

DEV void phase_inproj(const Params& p, int l, unsigned char* smem) {
  const int tid = ltid(), lane = tid & 63, wid = tid >> 6, wr = wid >> 1, wc = wid & 1, fr = lane & 15, fq = lane >> 4;
  const bf16* H = (const bf16*)(p.ws + WS_H);
  const bf16* W = (const bf16*)(p.ws + WS_W + (size_t)l * SZ_WL + O_WIN);
  bf16* NAQ = (bf16*)(p.ws + WS_NAQ); bf16* NAK = (bf16*)(p.ws + WS_NAK); bf16* NAVT = (bf16*)(p.ws + WS_NAVT);
  bf16* POOLU = (bf16*)(p.ws + WS_POOLU); bf16* CQ = (bf16*)(p.ws + WS_CQ); bf16* CKV = (bf16*)(p.ws + WS_CKV);
  float* KR = (float*)(p.ws + WS_KR);
  const int nmain = 8 * 2 * 19 * 8, nbig = nmain + 4 * 19, nitems = nbig + 264 * 4;
  for (int it = blockIdx.x; it < nitems; it += gridDim.x) {
    if (it < nbig) {
      int mt, j;
      if (it < nmain) { const int xq = it & 7, jq = it >> 3, ml = jq & 7, jn = jq >> 3; j = jn % 19; mt = ((jn / 19) * 8 + ml) * 8 + xq; }
      else { const int q = it - nmain; mt = 128 + q / 19; j = q % 19; }
      const int ntile = (j < 8) ? j : j + 4, row0 = mt * 256, n0 = ntile * 128;
      f32x4 acc[8][4]; zero_acc<8>(acc);
      gemm_mainloop<8, true>(acc, H + (size_t)row0 * D, D, 15u, nullptr, W + (size_t)n0 * 1024, 1024, 1024, smem);
      if (ntile == 22) {
#pragma unroll
        for (int m = 0; m < 8; ++m)
#pragma unroll
          for (int n = 0; n < 4; ++n) {
            const int col = wc * 64 + n * 16 + fq * 4, row = row0 + wr * 128 + m * 16 + fr;
            if (col < 32) *(float4*)(KR + (size_t)row * 32 + col) = make_float4(acc[m][n][0], acc[m][n][1], acc[m][n][2], acc[m][n][3]);
          }
        __syncthreads();
      } else {
        bf16* dst; int ld, c0 = n0 & 511;
        if (ntile < 4) {
          dst = NAQ; ld = 512;
          const float sc = 0.125f * 1.4426950408889634f;
#pragma unroll
          for (int m = 0; m < 8; ++m)
#pragma unroll
            for (int n = 0; n < 4; ++n) acc[m][n] *= sc;
        } else if (ntile < 8) { dst = NAK; ld = 512; }
        else if (ntile < 16) { dst = POOLU; ld = 512; }
        else if (ntile < 20) { dst = CQ; ld = 512; }
        else { dst = CKV; ld = 256; c0 = n0 - 2560; }
        bf16* db = dst + (size_t)row0 * ld + c0;
        epi_store<8, false>(acc, smem, [=](int r, int ch) -> bf16* { return db + (size_t)r * ld + ch * 8; });
      }
    } else {
      const int q = it - nbig, mt = q >> 2, ntile = 8 + (q & 3), row0 = mt * 128, n0 = ntile * 128;
      const RowInfo r0 = rowinfo(row0);
      f32x4 acc[4][4]; zero_acc<4>(acc);
      gemm_mainloop<4, false>(acc, H + (size_t)row0 * D, D, 3u, nullptr, W + (size_t)n0 * 1024, 1024, 1024, smem);
      const int c0 = n0 - 1024;
      bf16* vb = NAVT + (size_t)r0.b * 8 * 64 * TALL + r0.tall;
      epi_store<4, true>(acc, smem, [=](int cl, int ch) -> bf16* { return vb + (size_t)(c0 + cl) * TALL + ch * 8; });
    }
  }
}

DEV float rope_inv(int f) {
  const float tb[8] = {1.f, 0.316227766f, 0.1f, 0.0316227766f, 0.01f, 0.00316227766f, 0.001f, 0.000316227766f};
  float r = tb[0];
#pragma unroll
  for (int i = 1; i < 8; ++i) r = (f == i) ? tb[i] : r;
  return r;
}

template <int HW>
DEV void pool_diff16(const bf16* ub, bf16* db, int t0, int L) {
  constexpr int NR = 16 + 2 * HW - 1;
  float v0[NR], v1[NR];
#pragma unroll
  for (int i = 0; i < NR; ++i) {
    const int t = t0 - HW + i;
    const bool ok = (t >= 0) && (t < L);
    const unsigned u = *(const unsigned*)(ub + (size_t)(ok ? t : t0) * 512);
    v0[i] = ok ? __uint_as_float(u << 16) : 0.f; v1[i] = ok ? __uint_as_float(u & 0xffff0000u) : 0.f;
  }
#pragma unroll
  for (int rr = 0; rr < 16; ++rr) {
    float s0 = 0.f, s1 = 0.f;
#pragma unroll
    for (int k = 0; k < 2 * HW; ++k) { s0 += v0[rr + k]; s1 += v1[rr + k]; }
    const int t = t0 + rr;
    const float inv = 1.f / (float)(min(t + HW, L) - max(t - HW, 0));
    *(unsigned*)(db + (size_t)rr * 512) = pack2(s0 * inv - v0[rr + HW], s1 * inv - v1[rr + HW]);
  }
}

DEV void phase_mlaproj(const Params& p, int l, unsigned char* smem) {
  TILE_IDS
  const bf16* CQ = (const bf16*)(p.ws + WS_CQ); const bf16* CKV = (const bf16*)(p.ws + WS_CKV);
  const float* KR = (const float*)(p.ws + WS_KR);
  const bf16* POOLU = (const bf16*)(p.ws + WS_POOLU); bf16* POOLD = (bf16*)(p.ws + WS_POOLD);
  bf16* QF = (bf16*)(p.ws + WS_QF); bf16* KF = (bf16*)(p.ws + WS_KF); bf16* VT = (bf16*)(p.ws + WS_VT);
  const bf16* WUQ = (const bf16*)(p.ws + WS_W + (size_t)l * SZ_WL + O_WUQ);
  const bf16* WUKV = (const bf16*)(p.ws + WS_W + (size_t)l * SZ_WL + O_WUKV);
  float* sR = (float*)(smem + LDS_GEMM);
  constexpr int N_UQ = 264 * 6, N_UKV = 264 * 8, N_ROPE = 264, N_PD = MT / 16;
  const int nitems = N_UQ + N_UKV + N_ROPE + N_PD;
  const float QSCALE = 0.10206207261596575f * 1.4426950408889634f;
  for (int it = blockIdx.x; it < nitems; it += gridDim.x) {
    if (it < N_UQ + N_UKV) {
      const bool isq = it < N_UQ;
      const int q = isq ? it : it - N_UQ;
      const int xq = q & 7, jq = q >> 3;
      const int mt = (isq ? jq / 6 : jq >> 3) * 8 + xq, ntile = isq ? jq % 6 : jq & 7, row0 = mt * 128, n0 = ntile * 128;
      const int KD = isq ? 512 : 256;
      const bf16* A = isq ? CQ : CKV; const bf16* W = isq ? WUQ : WUKV;
      {
        const int rl = tid >> 1, half = tid & 1;
        const bf16* rp = A + (size_t)(row0 + rl) * KD + half * (KD / 2);
        float ss = 0.f;
        for (int i = 0; i < KD / 16; ++i) {
          const uint4 v = *(const uint4*)(rp + i * 8);
          const unsigned uu[4] = {v.x, v.y, v.z, v.w};
#pragma unroll
          for (int e = 0; e < 4; ++e) { const float a = __uint_as_float(uu[e] << 16), b = __uint_as_float(uu[e] & 0xffff0000u); ss += a * a + b * b; }
        }
        ss += __shfl_xor(ss, 1);
        if (!half) sR[rl] = rsqrtf(ss / (float)KD + EPS);
      }
      f32x4 acc[4][4]; zero_acc<4>(acc);
      const bf16* a0 = A + (size_t)row0 * KD;
      const bf16* b0 = W + (size_t)n0 * KD;
      const RowInfo r0 = rowinfo(row0);
      if (isq) {
        gemm_mainloop<4, true>(acc, a0, KD, 3u, nullptr, b0, KD, KD, smem);
#pragma unroll
        for (int m = 0; m < 4; ++m) {
          const int rl = wr * 64 + m * 16 + fr, t = r0.t + rl;
          const float rs = sR[rl] * QSCALE;
#pragma unroll
          for (int n = 0; n < 4; ++n) {
            const int colb = n0 + wc * 64 + n * 16;
            const int h = colb / 96, cb = colb - h * 96;
#pragma unroll
            for (int j = 0; j < 4; ++j) {
              float v = acc[m][n][j] * rs;
              const float pv = __shfl_xor(v, 32);
              if (cb >= 64 && !r0.ctx) {
                const int hf = (cb - 64) >> 4, ii = fq * 4 + j, f = ii & 7;
                const float pos = (float)(hf ? (t & 63) : (t >> 6));
                float sn, cs; __sincosf(pos * rope_inv(f), &sn, &cs);
                v = (ii >> 3) ? (pv * sn + v * cs) : (v * cs - pv * sn);
              }
              acc[m][n][j] = v;
            }
          }
        }
        bf16* db = QF + (size_t)row0 * 768 + n0;
        epi_store<4, false>(acc, smem, [=](int r, int ch) -> bf16* { return db + (size_t)r * 768 + ch * 8; });
      } else if (ntile < 4) {
        gemm_mainloop<4, true>(acc, a0, KD, 3u, nullptr, b0, KD, KD, smem);
#pragma unroll
        for (int m = 0; m < 4; ++m) {
          const float rs = sR[wr * 64 + m * 16 + fr];
#pragma unroll
          for (int n = 0; n < 4; ++n) acc[m][n] *= rs;
        }
        bf16* kb = KF + ((size_t)(r0.b * 8 + 2 * ntile) * TALL + r0.tall) * 96;
        epi_store<4, false>(acc, smem, [=](int r, int ch) -> bf16* { return kb + ((size_t)(ch >> 3) * TALL + r) * 96 + (ch & 7) * 8; });
      } else {
        gemm_mainloop<4, false>(acc, a0, KD, 3u, nullptr, b0, KD, KD, smem);
#pragma unroll
        for (int m = 0; m < 4; ++m)
#pragma unroll
          for (int j = 0; j < 4; ++j) {
            const float rs = sR[wr * 64 + m * 16 + fq * 4 + j];
#pragma unroll
            for (int n = 0; n < 4; ++n) acc[m][n][j] *= rs;
          }
        bf16* vb = VT + (size_t)(r0.b * 8 + 2 * (ntile - 4)) * 64 * TALL + r0.tall;
        epi_store<4, true>(acc, smem, [=](int cl, int ch) -> bf16* { return vb + (size_t)cl * TALL + ch * 8; });
      }
    } else if (it < N_UQ + N_UKV + N_ROPE) {
      const int row0 = (it - N_UQ - N_UKV) * 128;
      for (int e = tid; e < 128 * 16; e += 256) {
        const int rl = e >> 4, pp = e & 15, hf = pp >> 3, f = pp & 7, row = row0 + rl;
        const RowInfo ri = rowinfo(row);
        const float x1 = KR[(size_t)row * 32 + hf * 16 + f], x2 = KR[(size_t)row * 32 + hf * 16 + 8 + f];
        float o1 = x1, o2 = x2;
        if (!ri.ctx) {
          const float pos = (float)(hf ? (ri.t & 63) : (ri.t >> 6));
          float sn, cs; __sincosf(pos * rope_inv(f), &sn, &cs);
          o1 = x1 * cs - x2 * sn; o2 = x1 * sn + x2 * cs;
        }
        const bf16 b1 = f2bf(o1), b2 = f2bf(o2);
#pragma unroll
        for (int h = 0; h < 8; ++h) {
          bf16* kd = KF + ((size_t)(ri.b * 8 + h) * TALL + ri.tall) * 96 + 64 + hf * 16 + f;
          kd[0] = b1; kd[8] = b2;
        }
      }
    } else {
      const int row0 = (it - N_UQ - N_UKV - N_ROPE) * 16;
      const int ch = tid * 2, g = ch >> 7;
      const RowInfo r0 = rowinfo(row0);
      const bf16* ub = POOLU + (size_t)r0.sbase * 512 + ch;
      bf16* db = POOLD + (size_t)row0 * 512 + ch;
      if (g == 0) pool_diff16<1>(ub, db, r0.t, r0.L);
      else if (g == 1) pool_diff16<2>(ub, db, r0.t, r0.L);
      else if (g == 2) pool_diff16<4>(ub, db, r0.t, r0.L);
      else pool_diff16<8>(ub, db, r0.t, r0.L);
    }
  }
}

struct FlashDesc {
  const bf16* q; int qstride;
  bf16* o; int ostride;
  const bf16* kwin; const bf16* kseq; int kstride;
  const bf16* vbase;
  int nwin, r0a, nchunks;
  int qr0;
  const float* rpb;
};

template <int DQK>
DEV void flash_unit(const FlashDesc& fd, unsigned char* smem) {
  constexpr int NKP = DQK / 32, KBYTES = NKP * 4096, STAGE = KBYTES + 8192, NKS = DQK / 32;
  const int tid = ltid(), lane = tid & 63, w = tid >> 6, fr = lane & 15, fq = lane >> 4;
  float* sRpb = (float*)(smem + 3 * STAGE);
  if (fd.nwin > 0) { for (int e = tid; e < 465; e += 256) sRpb[e] = fd.rpb[e] * 1.4426950408889634f; }
  bf16x8 qf[2][NKS];
#pragma unroll
  for (int nt = 0; nt < 2; ++nt)
#pragma unroll
    for (int ks = 0; ks < NKS; ++ks) qf[nt][ks] = *(const bf16x8*)(fd.q + (size_t)(w * 32 + nt * 16 + fr) * fd.qstride + ks * 32 + fq * 8);
  f32x4 O[4][2];
#pragma unroll
  for (int m = 0; m < 4; ++m) { O[m][0] = f32x4{0.f, 0.f, 0.f, 0.f}; O[m][1] = f32x4{0.f, 0.f, 0.f, 0.f}; }
  float mrun[2] = {0.f, 0.f};
  f32x4 Lacc[2] = {f32x4{0.f, 0.f, 0.f, 0.f}, f32x4{0.f, 0.f, 0.f, 0.f}};
  bf16x8 ones; { union { uint4 u; bf16x8 b; } cv; cv.u = make_uint4(0x3F803F80u, 0x3F803F80u, 0x3F803F80u, 0x3F803F80u); ones = cv.b; }
  bool first = true;
  const int srow = tid >> 2, sch = (tid & 3) ^ swz4((tid >> 4) & 3);
  const int skey = ((srow >> 5) * 32) + (((srow >> 2) & 3) * 8) + (((srow >> 4) & 1) * 4) + (srow & 3);
  const size_t koff = (size_t)skey * fd.kstride + sch * 8, voff = (size_t)srow * TALL + sch * 8;
  unsigned char* ldst = smem + tid * 16;
#define F_GLDS(c_, stg_) do { const int c__ = (c_); const bf16* kp; const bf16* vp; \
    if (c__ < fd.nwin) { const int kr = fd.r0a + c__; kp = fd.kwin + (size_t)kr * 64 * fd.kstride; vp = fd.vbase + CTX + kr * 64; } \
    else { const int cc = c__ - fd.nwin; kp = fd.kseq + (size_t)cc * 64 * fd.kstride; vp = fd.vbase + cc * 64; } \
    unsigned char* d_ = ldst + (stg_) * STAGE; \
    _Pragma("unroll") for (int p_ = 0; p_ < NKP; ++p_) __builtin_amdgcn_global_load_lds((const unsigned*)(kp + koff + p_ * 32), (unsigned*)(d_ + p_ * 4096), 16, 0, 0); \
    __builtin_amdgcn_global_load_lds((const unsigned*)(vp + voff), (unsigned*)(d_ + KBYTES), 16, 0, 0); \
    __builtin_amdgcn_global_load_lds((const unsigned*)(vp + voff + 32), (unsigned*)(d_ + KBYTES + 4096), 16, 0, 0); } while (0)
  const int rdo = fr * 64 + ((fq ^ swz4(fr >> 2)) << 4);
  const int nch = fd.nchunks;
  const int qr = fd.qr0 + (w >> 1);
  const int r0q = min(max(qr - 4, 0), 120);
  asm volatile("s_waitcnt vmcnt(0)" ::: "memory");
  F_GLDS(0, 0);
  if (nch > 1) F_GLDS(1, 1);
  int st = 0, st2 = 2;
  for (int c = 0; c < nch; ++c) {
    if (c + 1 < nch) { if (DQK == 96) asm volatile("s_waitcnt vmcnt(5) lgkmcnt(0)" ::: "memory"); else asm volatile("s_waitcnt vmcnt(4) lgkmcnt(0)" ::: "memory"); }
    else asm volatile("s_waitcnt vmcnt(0) lgkmcnt(0)" ::: "memory");
    __builtin_amdgcn_s_barrier();
    asm volatile("" ::: "memory");
    if (c + 2 < nch) F_GLDS(c + 2, st2);
    const unsigned char* s = smem + st * STAGE;
    st = (st == 2) ? 0 : st + 1; st2 = (st2 == 2) ? 0 : st2 + 1;
    const bool iswin = c < fd.nwin;
    const int keyrow = fd.r0a + c;
    const bool active = !iswin || (keyrow >= r0q && keyrow < r0q + 8);
    if (active) {
      f32x4 S[4][2];
      {
        const float c0 = first ? 0.f : -mrun[0], c1 = first ? 0.f : -mrun[1];
        const f32x4 ci0 = f32x4{c0, c0, c0, c0}, ci1 = f32x4{c1, c1, c1, c1};
        bf16x8 kf[4][NKS];
#pragma unroll
        for (int m = 0; m < 4; ++m)
#pragma unroll
          for (int ks = 0; ks < NKS; ++ks) kf[m][ks] = *(const bf16x8*)(s + ks * 4096 + m * 1024 + rdo);
#pragma unroll
        for (int m = 0; m < 4; ++m)
#pragma unroll
          for (int ks = 0; ks < NKS; ++ks) {
            S[m][0] = __builtin_amdgcn_mfma_f32_16x16x32_bf16(kf[m][ks], qf[0][ks], ks == 0 ? ci0 : S[m][0], 0, 0, 0);
            S[m][1] = __builtin_amdgcn_mfma_f32_16x16x32_bf16(kf[m][ks], qf[1][ks], ks == 0 ? ci1 : S[m][1], 0, 0, 0);
          }
      }
      bf16x8 vf[4][2];
#pragma unroll
      for (int m = 0; m < 4; ++m)
#pragma unroll
        for (int k2 = 0; k2 < 2; ++k2) {
          vf[m][k2] = *(const bf16x8*)(s + KBYTES + k2 * 4096 + m * 1024 + rdo);
        }
      if (iswin) {
        const float* brow = sRpb + (keyrow - qr + 7) * 31;
#pragma unroll
        for (int nt = 0; nt < 2; ++nt) {
          const int qc = (w & 1) * 32 + nt * 16 + fr;
          const int win0 = min(max(qc - 8, 0), 48);
#pragma unroll
          for (int m = 0; m < 4; ++m) {
            float bv[4];
#pragma unroll
            for (int j = 0; j < 4; ++j) bv[j] = brow[min(max((m >> 1) * 32 + fq * 8 + (m & 1) * 4 + j - qc + 15, 0), 30)];
#pragma unroll
            for (int j = 0; j < 4; ++j) {
              const int kc = (m >> 1) * 32 + fq * 8 + (m & 1) * 4 + j;
              const float sv = S[m][nt][j] + bv[j];
              S[m][nt][j] = ((kc >= win0) && (kc < win0 + 16)) ? sv : -1e30f;
            }
          }
        }
      }
      bf16x8 pf[2][2];
#pragma unroll
      for (int nt = 0; nt < 2; ++nt) {
        float mx = __builtin_fmaxf(__builtin_fmaxf(S[0][nt][0], S[0][nt][1]), S[0][nt][2]);
        mx = __builtin_fmaxf(__builtin_fmaxf(mx, S[0][nt][3]), S[1][nt][0]);
        mx = __builtin_fmaxf(__builtin_fmaxf(mx, S[1][nt][1]), S[1][nt][2]);
        mx = __builtin_fmaxf(__builtin_fmaxf(mx, S[1][nt][3]), S[2][nt][0]);
        mx = __builtin_fmaxf(__builtin_fmaxf(mx, S[2][nt][1]), S[2][nt][2]);
        mx = __builtin_fmaxf(__builtin_fmaxf(mx, S[2][nt][3]), S[3][nt][0]);
        mx = __builtin_fmaxf(__builtin_fmaxf(mx, S[3][nt][1]), S[3][nt][2]);
        mx = __builtin_fmaxf(mx, S[3][nt][3]);
        mx = quad_max(mx);
        if (first || __ballot(mx > 8.f) != 0ull) {
          const float dm = first ? mx : fmaxf(mx, 0.f);
          const float alpha = __builtin_amdgcn_exp2f(-dm);
          mrun[nt] += dm; Lacc[nt] *= alpha;
#pragma unroll
          for (int m = 0; m < 4; ++m) { O[m][nt] *= alpha; S[m][nt] -= dm; }
        }
        unsigned pu[4][2];
#pragma unroll
        for (int m = 0; m < 4; ++m) {
          const float e0 = __builtin_amdgcn_exp2f(S[m][nt][0]), e1 = __builtin_amdgcn_exp2f(S[m][nt][1]);
          const float e2 = __builtin_amdgcn_exp2f(S[m][nt][2]), e3 = __builtin_amdgcn_exp2f(S[m][nt][3]);
          pu[m][0] = pack2(e0, e1); pu[m][1] = pack2(e2, e3);
        }
#pragma unroll
        for (int k2 = 0; k2 < 2; ++k2) {
          union { uint4 u; bf16x8 b; } cv; cv.u = make_uint4(pu[2 * k2][0], pu[2 * k2][1], pu[2 * k2 + 1][0], pu[2 * k2 + 1][1]);
          pf[nt][k2] = cv.b;
        }
      }
#pragma unroll
      for (int m = 0; m < 4; ++m)
#pragma unroll
        for (int k2 = 0; k2 < 2; ++k2) {
          O[m][0] = __builtin_amdgcn_mfma_f32_16x16x32_bf16(vf[m][k2], pf[0][k2], O[m][0], 0, 0, 0);
          O[m][1] = __builtin_amdgcn_mfma_f32_16x16x32_bf16(vf[m][k2], pf[1][k2], O[m][1], 0, 0, 0);
        }
#pragma unroll
      for (int k2 = 0; k2 < 2; ++k2) {
        Lacc[0] = __builtin_amdgcn_mfma_f32_16x16x32_bf16(ones, pf[0][k2], Lacc[0], 0, 0, 0);
        Lacc[1] = __builtin_amdgcn_mfma_f32_16x16x32_bf16(ones, pf[1][k2], Lacc[1], 0, 0, 0);
      }
      first = false;
    }
  }
#pragma unroll
  for (int nt = 0; nt < 2; ++nt) {
    const float lt = Lacc[nt][0];
    const float il = 1.f / lt;
    bf16* op = fd.o + (size_t)(w * 32 + nt * 16 + fr) * fd.ostride + fq * 4;
#pragma unroll
    for (int m = 0; m < 4; ++m) {
      uint2 o; o.x = pack2(O[m][nt][0] * il, O[m][nt][1] * il); o.y = pack2(O[m][nt][2] * il, O[m][nt][3] * il);
      *(uint2*)(op + m * 16) = o;
    }
  }
  __syncthreads();
}

#ifndef MIXONLY
#define MIXONLY -1
#endif
#define MIXON(k) (MIXONLY == -1 || MIXONLY == (k))
DEV void phase_mixers(const Params& p, int l, unsigned char* smem) {
  TILE_IDS
  bf16* NAQ = (bf16*)(p.ws + WS_NAQ); const bf16* NAK = (const bf16*)(p.ws + WS_NAK); const bf16* NAVT = (const bf16*)(p.ws + WS_NAVT);
  const bf16* POOLD = (const bf16*)(p.ws + WS_POOLD); bf16* OPOOL = (bf16*)(p.ws + WS_POOLU); bf16* OMLA = (bf16*)(p.ws + WS_CQ);
  const bf16* QF = (const bf16*)(p.ws + WS_QF);
  const bf16* KF = (const bf16*)(p.ws + WS_KF); const bf16* VT = (const bf16*)(p.ws + WS_VT);
  const bf16* WPL = (const bf16*)(p.ws + WS_W + (size_t)l * SZ_WL + O_WPL);
  constexpr int N_MLA = 2048, N_NA = 2048;
  const int n_ctx = (l == 0) ? 128 : 0;
  const int n_flash = N_MLA + N_NA + n_ctx;
  const int n_pool = (l == 0 ? 264 : 256) * 4;
  const int nitems = n_flash + n_pool;
  for (int it = blockIdx.x; it < nitems; it += gridDim.x) {
    if (it < n_flash) {
      FlashDesc fd; fd.nwin = 0; fd.r0a = 0; fd.qr0 = 0; fd.rpb = nullptr; fd.kwin = nullptr; fd.ostride = 512;
      bool is96;
      if (it < N_MLA) {
        const int x = it & 7, slot = it >> 3, pair = (slot >> 6) * 8 + x, qb = slot & 63, b = pair >> 3, h = pair & 7;
        is96 = true;
        fd.q = QF + (size_t)(b * SEQ + qb * 128) * 768 + h * 96; fd.qstride = 768;
        fd.o = OMLA + (size_t)(b * SEQ + qb * 128) * 512 + h * 64;
        fd.kseq = KF + (size_t)pair * TALL * 96; fd.kstride = 96; fd.vbase = VT + (size_t)pair * 64 * TALL;
        fd.nchunks = TALL / 64;
      } else if (it < N_MLA + N_NA) {
        const int q = it - N_MLA, xq = q & 7, slot = q >> 3, pair = (slot >> 6) * 8 + xq, rp = slot & 63, b = pair >> 3, h = pair & 7, r = rp * 2;
        const int r0a = min(max(r - 4, 0), 120), r0b = min(max(r - 3, 0), 120);
        is96 = false;
        fd.q = NAQ + (size_t)(b * SEQ + r * 64) * 512 + h * 64; fd.qstride = 512; fd.o = NAQ + (size_t)(b * SEQ + r * 64) * 512 + h * 64;
        fd.kwin = NAK + (size_t)(b * SEQ) * 512 + h * 64; fd.kseq = NAK + (size_t)(NLAT + b * CTX) * 512 + h * 64; fd.kstride = 512;
        fd.vbase = NAVT + (size_t)pair * 64 * TALL;
        fd.nwin = r0b + 8 - r0a; fd.r0a = r0a; fd.nchunks = fd.nwin + 4; fd.qr0 = r;
        fd.rpb = p.in[11] + ((size_t)l * 8 + h) * 465;
      } else {
        const int q = it - N_MLA - N_NA;
        const int kind = q >> 6, u = q & 63, pair = u >> 1, qb = u & 1, b = pair >> 3, h = pair & 7;
        fd.nchunks = 4;
        if (kind == 0) {
          is96 = false;
          fd.q = NAQ + (size_t)(NLAT + b * CTX + qb * 128) * 512 + h * 64; fd.qstride = 512; fd.o = NAQ + (size_t)(NLAT + b * CTX + qb * 128) * 512 + h * 64;
          fd.kseq = NAK + (size_t)(NLAT + b * CTX) * 512 + h * 64; fd.kstride = 512; fd.vbase = NAVT + (size_t)pair * 64 * TALL;
        } else {
          is96 = true;
          fd.q = QF + (size_t)(NLAT + b * CTX + qb * 128) * 768 + h * 96; fd.qstride = 768; fd.o = OMLA + (size_t)(NLAT + b * CTX + qb * 128) * 512 + h * 64;
          fd.kseq = KF + (size_t)pair * TALL * 96; fd.kstride = 96; fd.vbase = VT + (size_t)pair * 64 * TALL;
        }
      }
      if (is96) flash_unit<96>(fd, smem); else flash_unit<64>(fd, smem);
    } else {
      const int q = it - n_flash, mt = q >> 2, g = q & 3, row0 = mt * 128;
      f32x4 acc[4][4]; zero_acc<4>(acc);
      gemm_mainloop<4, true>(acc, POOLD + (size_t)row0 * 512 + g * 128, 512, 3u, nullptr, WPL + (size_t)g * 128 * 128, 128, 128, smem);
      const float* psc = p.in[13] + l * 512 + g * 128;
#pragma unroll
      for (int n = 0; n < 4; ++n) {
        const float4 sc = *(const float4*)(psc + wc * 64 + n * 16 + fq * 4);
#pragma unroll
        for (int m = 0; m < 4; ++m) { acc[m][n][0] *= sc.x; acc[m][n][1] *= sc.y; acc[m][n][2] *= sc.z; acc[m][n][3] *= sc.w; }
      }
      bf16* db = OPOOL + (size_t)row0 * 512 + g * 128;
      epi_store<4, false>(acc, smem, [=](int r, int ch) -> bf16* { return db + (size_t)r * 512 + ch * 8; });
    }
  }
}

DEV void phase_merge(const Params& p, int l, int mtiles, unsigned char* smem) {
  TILE_IDS
  const bf16* H = (const bf16*)(p.ws + WS_H);
  const bf16* WG = (const bf16*)(p.ws + WS_W + (size_t)l * SZ_WL + O_WG);
  bf16* GATED = (bf16*)(p.ws + WS_GATED);
  const int nitems = mtiles * 8;
  for (int it = blockIdx.x; it < nitems; it += gridDim.x) {
    const int xq = it & 7, jq = it >> 3, mt = (jq >> 3) * 8 + xq, ntile = jq & 7, row0 = mt * 128, n0 = ntile * 128;
    f32x4 gsum[4][4]; zero_acc<4>(gsum);
#pragma unroll 1
    for (int k = 0; k < 3; ++k) {
      f32x4 ag[4][4]; zero_acc<4>(ag);
      gemm_mainloop<4, true>(ag, H + (size_t)row0 * D, D, 3u, nullptr, WG + (size_t)(k * 1024 + n0) * 1024, 1024, 1024, smem);
      const bf16* pb = (const bf16*)(p.ws + ((k == 0) ? WS_PB0 : ((k == 1) ? WS_PB1 : WS_PB2))) + (size_t)row0 * D + n0;
#pragma unroll
      for (int m = 0; m < 4; ++m)
#pragma unroll
        for (int n = 0; n < 4; ++n) {
          const uint2 u = *(const uint2*)(pb + (size_t)(wr * 64 + m * 16 + fr) * D + wc * 64 + n * 16 + fq * 4);
          const float p0 = __uint_as_float(u.x << 16), p1 = __uint_as_float(u.x & 0xffff0000u), p2 = __uint_as_float(u.y << 16), p3 = __uint_as_float(u.y & 0xffff0000u);
          gsum[m][n][0] += p0 * __builtin_amdgcn_rcpf(1.f + __expf(-ag[m][n][0])); gsum[m][n][1] += p1 * __builtin_amdgcn_rcpf(1.f + __expf(-ag[m][n][1]));
          gsum[m][n][2] += p2 * __builtin_amdgcn_rcpf(1.f + __expf(-ag[m][n][2])); gsum[m][n][3] += p3 * __builtin_amdgcn_rcpf(1.f + __expf(-ag[m][n][3]));
        }
    }
    bf16* db = GATED + (size_t)row0 * D + n0;
    epi_store<4, false>(gsum, smem, [=](int r, int ch) -> bf16* { return db + (size_t)r * D + ch * 8; });
  }
}

DEV void phase_gemm_out(const Params& p, const bf16* A, int lda, int K, const bf16* W, bf16* OUT, int mtiles, unsigned char* smem, int ngroups) {
  const int nbig = 128 * 8, per = nbig + (mtiles - 256) * 8, nitems = per * ngroups;
  for (int it = blockIdx.x; it < nitems; it += gridDim.x) {
    const int g = it / per, q = it - g * per;
    const bf16* Ag = A; const bf16* Wg = W; bf16* Og = OUT;
    if (ngroups == 3) {
      Ag = (const bf16*)(p.ws + ((g == 0) ? WS_NAQ : ((g == 1) ? WS_POOLU : WS_CQ)));
      Wg = W + (size_t)g * 1024 * 512;
      Og = (bf16*)(p.ws + ((g == 0) ? WS_PB0 : ((g == 1) ? WS_PB1 : WS_PB2)));
    }
    if (q < nbig) {
      const int xq = q & 7, jq = q >> 3, row0 = ((jq >> 3) * 8 + xq) * 256, n0 = (jq & 7) * 128;
      f32x4 acc[8][4]; zero_acc<8>(acc);
      gemm_mainloop<8, true>(acc, Ag + (size_t)row0 * lda, lda, 15u, nullptr, Wg + (size_t)n0 * K, K, K, smem);
      bf16* db = Og + (size_t)row0 * D + n0;
      epi_store<8, false>(acc, smem, [=](int r, int ch) -> bf16* { return db + (size_t)r * D + ch * 8; });
    } else {
      const int q2 = q - nbig, row0 = NLAT + (q2 >> 3) * 128, n0 = (q2 & 7) * 128;
      f32x4 acc[4][4]; zero_acc<4>(acc);
      gemm_mainloop<4, true>(acc, Ag + (size_t)row0 * lda, lda, 3u, nullptr, Wg + (size_t)n0 * K, K, K, smem);
      bf16* db = Og + (size_t)row0 * D + n0;
      epi_store<4, false>(acc, smem, [=](int r, int ch) -> bf16* { return db + (size_t)r * D + ch * 8; });
    }
  }
}

DEV void phase_ffn_up(const Params& p, int l, unsigned char* smem) {
  const int tid = ltid(), lane = tid & 63, wid = tid >> 6, wr = wid >> 1, wc = wid & 1, fr = lane & 15, fq = lane >> 4;
  const bf16* H = (const bf16*)(p.ws + WS_H);
  const bf16* WUP = (const bf16*)(p.ws + WS_W + (size_t)l * SZ_WL + O_WUP);
  bf16* ACT = (bf16*)(p.ws + WS_ACT);
  const float* cw = p.in[21] + (size_t)l * 3 * 2 * DFF; const float* cb = p.in[22] + (size_t)l * 2 * DFF;
  const int nmain = 8 * 2 * 44 * 8, nbig = nmain + 4 * 44;
  const int nitems = nbig + ((l == 0) ? 8 * 44 : 0);
  bf16* U = (bf16*)smem;
  for (int it = blockIdx.x; it < nitems; it += gridDim.x) {
    int sbase, L, ti, ntile;
    if (it < nbig) {
      int mi;
      if (it < nmain) { const int xq = it & 7, jq = it >> 3, ml = jq & 7, jn = jq >> 3; ntile = jn % 44; mi = ((jn / 44) * 8 + ml) * 8 + xq; }
      else { const int q = it - nmain; mi = 128 + q / 44; ntile = q % 44; }
      const int b = mi / 33; ti = mi % 33; sbase = b * SEQ; L = SEQ;
    } else { const int q2 = it - nbig, q = q2 / 44; ntile = q2 % 44; const int b = q >> 1; ti = q & 1; sbase = NLAT + b * CTX; L = CTX; }
    const int t0 = ti * 254;
    unsigned amask = 0;
#pragma unroll
    for (int i = 0; i < 4; ++i) { const int t = t0 - 1 + (tid >> 2) + 64 * i; amask |= (t >= 0 && t < L) ? (1u << i) : 0u; }
    f32x4 acc[8][4]; zero_acc<8>(acc);
    gemm_mainloop<8, true>(acc, H + ((ptrdiff_t)(sbase + t0 - 1)) * D, D, amask, (const bf16*)(p.ws + WS_BAR), WUP + (size_t)(ntile * 128) * 1024, 1024, 1024, smem);
#pragma unroll
    for (int m = 0; m < 8; ++m)
#pragma unroll
      for (int n = 0; n < 4; ++n) {
        uint2 o; o.x = pack2(acc[m][n][0], acc[m][n][1]); o.y = pack2(acc[m][n][2], acc[m][n][3]);
        *(uint2*)(U + (wr * 128 + m * 16 + fr) * 136 + wc * 64 + n * 16 + fq * 4) = o;
      }
    __syncthreads();
    {
      const int cq = (tid & 15) * 4, rg = tid >> 4, ca = ntile * 64 + cq, cbi = DFF + ca;
      const float4 wa0 = *(const float4*)(cw + ca), wa1 = *(const float4*)(cw + 2 * DFF + ca), wa2 = *(const float4*)(cw + 4 * DFF + ca), ba = *(const float4*)(cb + ca);
      const float4 wb0 = *(const float4*)(cw + cbi), wb1 = *(const float4*)(cw + 2 * DFF + cbi), wb2 = *(const float4*)(cw + 4 * DFF + cbi), bb = *(const float4*)(cb + cbi);
#define LD4(dst, ptr) { const uint2 u_ = *(const uint2*)(ptr); dst = make_float4(__uint_as_float(u_.x << 16), __uint_as_float(u_.x & 0xffff0000u), __uint_as_float(u_.y << 16), __uint_as_float(u_.y & 0xffff0000u)); }
      const int lr0 = rg * 16;
      float4 a0, a1, a2, b0, b1, b2;
      LD4(a0, U + max(lr0 - 1, 0) * 136 + cq) LD4(b0, U + max(lr0 - 1, 0) * 136 + 64 + cq)
      LD4(a1, U + lr0 * 136 + cq) LD4(b1, U + lr0 * 136 + 64 + cq)
      const float GC = -1.5957691216057308f * 1.4426950408889634f;
#pragma unroll 4
      for (int q = 0; q < 16; ++q) {
        const int lr = lr0 + q, t = t0 - 1 + lr;
        LD4(a2, U + min(lr + 1, 255) * 136 + cq) LD4(b2, U + min(lr + 1, 255) * 136 + 64 + cq)
        if (lr >= 1 && lr <= 254 && t < L) {
          float o[4];
#define CONV1(X) { const float av = fmaf(wa2.X, a2.X, fmaf(wa1.X, a1.X, fmaf(wa0.X, a0.X, ba.X))); const float bv = fmaf(wb2.X, b2.X, fmaf(wb1.X, b1.X, fmaf(wb0.X, b0.X, bb.X))); \
            const float u_ = av * fmaf(av * av, 0.044715f, 1.f); ov = av * bv * __builtin_amdgcn_rcpf(1.f + __builtin_amdgcn_exp2f(GC * u_)); }
          float ov;
          CONV1(x) o[0] = ov; CONV1(y) o[1] = ov; CONV1(z) o[2] = ov; CONV1(w) o[3] = ov;
#undef CONV1
          uint2 pk; pk.x = pack2(o[0], o[1]); pk.y = pack2(o[2], o[3]);
          *(uint2*)(ACT + (size_t)(sbase + t) * DFF + ca) = pk;
        }
        a0 = a1; a1 = a2; b0 = b1; b1 = b2;
      }
#undef LD4
    }
    __syncthreads();
  }
}

#define XB_TMO      128
#define XB_XCNT(j)  (256  + 64 * (j))
#define XB_XSUB(j)  (1280 + 64 * (j))
#define XB_XGEN(j)  (2304 + 64 * (j))
#define XB_TOP      3328
#define XB_TOPGEN   3392
#define XCD_BAR_WORDS 3456
#define XB_SPIN_CAP (1u << 18)
#define LAS __attribute__((address_space(3)))
DEV unsigned xb_ld(unsigned* p)              { return __hip_atomic_load(p, __ATOMIC_RELAXED, __HIP_MEMORY_SCOPE_AGENT); }
DEV unsigned xb_add(unsigned* p, unsigned v) { return __hip_atomic_fetch_add(p, v, __ATOMIC_RELAXED, __HIP_MEMORY_SCOPE_AGENT); }
DEV unsigned xb_xcc_id() { return (unsigned)__builtin_amdgcn_s_getreg((3 << 11) | 20) & 0xFu; }
#define XB_SPIN(cond, bar) do { unsigned _sp = 0; while (cond) { __builtin_amdgcn_s_sleep(1); \
    if ((++_sp & 255u) == 0u) { if (xb_ld(&(bar)[XB_TMO])) break; if (_sp > XB_SPIN_CAP) { atomicAdd(&(bar)[XB_TMO], 1u); break; } } } } while (0)
struct XcdBarrier { unsigned* bar; unsigned x; volatile LAS unsigned* st; };
DEV XcdBarrier xcd_barrier_post(unsigned* bar, volatile LAS unsigned* st) {
  XcdBarrier b; b.bar = bar; b.x = xb_xcc_id(); b.st = st;
  if (threadIdx.x == 0) (void)xb_add(&bar[XB_XCNT(b.x)], 1u);
  return b;
}
DEV void xcd_barrier_complete(unsigned* bar, unsigned x, unsigned& nloc, unsigned& nx) {
  const unsigned G = gridDim.x * gridDim.y * gridDim.z;
  unsigned sum, cnt, mine, sp = 0u;
  for (;;) {
    sum = 0u; cnt = 0u; mine = 0u;
#pragma unroll
    for (unsigned j = 0; j < 16; ++j) { const unsigned c = xb_ld(&bar[XB_XCNT(j)]); sum += c; cnt += (c > 0u) ? 1u : 0u; mine = (j == x) ? c : mine; }
    if (sum == G) break;
    __builtin_amdgcn_s_sleep(1);
    if ((++sp & 255u) == 0u) { if (xb_ld(&bar[XB_TMO])) break; if (sp > XB_SPIN_CAP) { atomicAdd(&bar[XB_TMO], 1u); break; } }
  }
  nloc = mine > 0u ? mine : 1u; nx = cnt > 0u ? cnt : 1u;
}
DEV void xcd_barrier(const XcdBarrier& b) {
  asm volatile("s_waitcnt vmcnt(0)" ::: "memory");
  __syncthreads();
  if (threadIdx.x == 0) {
    unsigned* bar = b.bar;
    __builtin_amdgcn_s_waitcnt(0);
    unsigned nloc = b.st[0], nx = b.st[1];
    if (nloc == 0u) { xcd_barrier_complete(bar, b.x, nloc, nx); b.st[0] = nloc; b.st[1] = nx; }
    const unsigned old = xb_add(&bar[XB_XSUB(b.x)], 1u);
    const unsigned gen = old / nloc;
    if (old + 1u == (gen + 1u) * nloc) {
      __builtin_amdgcn_fence(__ATOMIC_RELEASE, "agent");
      asm volatile("s_waitcnt vmcnt(0)" ::: "memory");
      const unsigned og = xb_add(&bar[XB_TOP], 1u);
      const unsigned tg = og / nx;
      if (og + 1u == (tg + 1u) * nx) xb_add(&bar[XB_TOPGEN], 1u);
      else XB_SPIN(xb_ld(&bar[XB_TOPGEN]) == tg, bar);
      __builtin_amdgcn_fence(__ATOMIC_ACQUIRE, "agent");
      xb_add(&bar[XB_XGEN(b.x)], 1u);
      asm volatile("s_waitcnt vmcnt(0)" ::: "memory");
    } else {
      XB_SPIN(xb_ld(&bar[XB_XGEN(b.x)]) == gen, bar);
      __builtin_amdgcn_fence(__ATOMIC_ACQUIRE, "agent");
      asm volatile("s_waitcnt vmcnt(0)" ::: "memory");
    }
  }
  __syncthreads();
}

constexpr int N_PHASES = 22;
DEV void run_phase(const Params& pin, int ph, unsigned char* smem) {
  Params p = pin;
  {
    size_t z = 0; asm volatile("" : "+s"(z));
    p.ws = pin.ws + z; p.out = pin.out + z;
  }
  if (ph == 0) { phase_prep(p, smem); return; }
  if (ph == 1) { phase_rows(p, 0, 0, MT); return; }
  const int l = (ph - 2) / 10, s = (ph - 2) % 10;
  const int mtiles = (l == 0) ? 264 : 256;
  const unsigned char* wl = p.ws + WS_W + (size_t)l * SZ_WL;
  switch (s) {
    case 0: phase_inproj(p, l, smem); break;
    case 1: phase_mlaproj(p, l, smem); break;
    case 2: phase_mixers(p, l, smem); break;
    case 3: phase_gemm_out(p, (const bf16*)(p.ws + WS_NAQ), 512, 512, (const bf16*)(wl + O_WBR), (bf16*)(p.ws + WS_PB0), mtiles, smem, 3); break;
    case 4: phase_merge(p, l, mtiles, smem); break;
    case 5: phase_gemm_out(p, (const bf16*)(p.ws + WS_GATED), D, D, (const bf16*)(wl + O_WO), (bf16*)(p.ws + WS_Y), mtiles, smem, 1); break;
    case 6: phase_rows(p, l, 1, mtiles * 128); break;
    case 7: phase_ffn_up(p, l, smem); break;
    case 8: phase_gemm_out(p, (const bf16*)(p.ws + WS_ACT), DFF, DFF, (const bf16*)(wl + O_WDN), (bf16*)(p.ws + WS_Y), mtiles, smem, 1); break;
    case 9: phase_rows(p, l, 2, mtiles * 128); break;
  }
}

__global__ void __launch_bounds__(256, 2) mega(Params p) {
  extern __shared__ __attribute__((aligned(16))) unsigned char smem[];
  volatile LAS unsigned* st = (volatile LAS unsigned*)(smem + LDS_GEMM + 1024);
  if (threadIdx.x == 0) { st[0] = 0u; st[1] = 0u; }
  __syncthreads();
  XcdBarrier xb;
  if (p.ph_hi - p.ph_lo > 1) xb = xcd_barrier_post((unsigned*)(p.ws + WS_BAR), st);
  for (int ph = p.ph_lo; ph < p.ph_hi; ++ph) {
    if (ph > p.ph_lo) {
      if (p.ph_hi > N_PHASES) cg::this_grid().sync();
      else xcd_barrier(xb);
    }
    run_phase(p, ph, smem);
  }
}

extern "C" void kernel_launch(void* const* d_in, const int* in_sizes, int n_in, void* d_out, int out_size, void* d_ws, size_t ws_size, hipStream_t stream) {
  static int grid = 0;
  if (grid == 0) {
    if (n_in != 24 || ws_size < WS_TOTAL) { fprintf(stderr, "kernel_launch: need 24 inputs and %zu bytes of workspace (got %d, %zu)\n", (size_t)WS_TOTAL, n_in, ws_size); grid = -1; return; }
    int dev = 0, cus = 0, per_cu = 0;
    hipGetDevice(&dev);
    hipDeviceGetAttribute(&cus, hipDeviceAttributeMultiprocessorCount, dev);
    if (hipFuncSetAttribute((const void*)mega, hipFuncAttributeMaxDynamicSharedMemorySize, LDS_BYTES) != hipSuccess) { fprintf(stderr, "hipFuncSetAttribute failed\n"); grid = -1; return; }
    if (hipOccupancyMaxActiveBlocksPerMultiprocessor(&per_cu, (const void*)mega, 256, LDS_BYTES) != hipSuccess || per_cu < 1) per_cu = 1;
    if (per_cu > 2) per_cu = 2;
    grid = cus * per_cu;
  }
  if (grid < 0) return;
  Params p{};
  for (int i = 0; i < 24; ++i) p.in[i] = (const float*)d_in[i];
  p.out = (float*)d_out; p.ws = (unsigned char*)d_ws;
#if ONE_LAUNCH
  if (hipMemsetAsync((unsigned char*)d_ws + WS_BAR, 0, XCD_BAR_WORDS * 4, stream) != hipSuccess) { fprintf(stderr, "barrier memset failed\n"); return; }
  p.ph_lo = 0; p.ph_hi = N_PHASES;
  void* args[] = {&p};
  hipError_t e = hipLaunchCooperativeKernel((const void*)mega, dim3(grid), dim3(256), args, LDS_BYTES, stream);
  if (e != hipSuccess) fprintf(stderr, "cooperative launch failed: %s (grid %d)\n", hipGetErrorString(e), grid);
#else
  for (int ph = 0; ph < N_PHASES; ++ph) {
    p.ph_lo = ph; p.ph_hi = ph + 1;
    hipLaunchKernelGGL(mega, dim3(grid), dim3(256), LDS_BYTES, stream, p);
  }
#endif
}
```

```cpp
#include <hip/hip_runtime.h>
#include <hip/hip_cooperative_groups.h>
#include <cstdio>
#include <cstdint>
namespace cg = cooperative_groups;

#ifndef ONE_LAUNCH
#define ONE_LAUNCH 1
#endif

typedef unsigned short bf16;
typedef __attribute__((ext_vector_type(8))) short bf16x8;
typedef __attribute__((ext_vector_type(4))) float f32x4;
#define DEV __device__ __forceinline__

constexpr int D = 1024, NB = 4, SEQ = 8192, CTX = 256;
constexpr int NLAT = NB * SEQ, NCTX = NB * CTX, MT = NLAT + NCTX;
constexpr int TALL = CTX + SEQ;
constexpr int INC = 5920, DFF = 2816;
constexpr float EPS = 1e-6f;

constexpr size_t SZ_WIN = (size_t)2944 * 1024 * 2, SZ_WG = (size_t)3072 * 1024 * 2, SZ_WUQ = (size_t)768 * 512 * 2,
                 SZ_WUKV = (size_t)1024 * 256 * 2, SZ_WBR = (size_t)3 * 1024 * 512 * 2, SZ_WO = (size_t)1024 * 1024 * 2,
                 SZ_WUP = (size_t)5632 * 1024 * 2, SZ_WDN = (size_t)1024 * 2816 * 2, SZ_WPL = (size_t)4 * 128 * 128 * 2;
constexpr size_t O_WIN = 0, O_WG = O_WIN + SZ_WIN, O_WUQ = O_WG + SZ_WG, O_WUKV = O_WUQ + SZ_WUQ, O_WBR = O_WUKV + SZ_WUKV,
                 O_WO = O_WBR + SZ_WBR, O_WUP = O_WO + SZ_WO, O_WDN = O_WUP + SZ_WUP, O_WPL = O_WDN + SZ_WDN, SZ_WL = O_WPL + SZ_WPL;
constexpr size_t WS_W = 0;
constexpr size_t WS_MOD = WS_W + 2 * SZ_WL;
constexpr size_t WS_XC = WS_MOD + 2 * 5 * 6144 * 4;
constexpr size_t WS_H = WS_XC + (size_t)NCTX * D * 4;
constexpr size_t SZ_R512 = (size_t)MT * 512 * 2;
constexpr size_t WS_A = WS_H + (size_t)MT * D * 2;
constexpr size_t WS_POOLU = WS_A;
constexpr size_t WS_CQ = WS_POOLU + SZ_R512;
constexpr size_t WS_CKV = WS_CQ + SZ_R512;
constexpr size_t WS_KR = WS_CKV + (size_t)MT * 256 * 2;
constexpr size_t WS_B = WS_KR + (size_t)MT * 32 * 4;
constexpr size_t WS_POOLD = WS_B;
constexpr size_t WS_QF = WS_POOLD + SZ_R512;
constexpr size_t WS_KF = WS_QF + (size_t)MT * 768 * 2;
constexpr size_t WS_VT = WS_KF + (size_t)NB * 8 * TALL * 96 * 2;
constexpr size_t WS_C = WS_VT + (size_t)NB * 8 * 64 * TALL * 2;
constexpr size_t WS_NAQ = WS_C;
constexpr size_t WS_NAK = WS_NAQ + SZ_R512;
constexpr size_t WS_NAVT = WS_NAK + SZ_R512;
constexpr size_t WS_END = WS_NAVT + (size_t)NB * 8 * 64 * TALL * 2;
constexpr size_t WS_GATED = WS_B;
constexpr size_t WS_Y = WS_C;
constexpr size_t WS_ACT = WS_A;
constexpr size_t WS_PB0 = WS_GATED, WS_PB1 = WS_GATED + (size_t)MT * D * 2, WS_PB2 = WS_NAK;
static_assert(WS_PB1 + (size_t)MT * D * 2 <= WS_C, "branch projections overflow region B");
constexpr size_t WS_BAR = (WS_END + 255) & ~(size_t)255;
constexpr size_t WS_TOTAL = WS_BAR + 3456 * 4;
static_assert(WS_ACT + (size_t)MT * DFF * 2 <= WS_C, "ACT overlaps Y");
static_assert(WS_GATED + (size_t)MT * D * 2 <= WS_KF, "GATED too big");

constexpr int LDS_GEMM = 73728;
constexpr int LDS_BYTES = LDS_GEMM + 2048;

struct Params {
  const float* in[24];
  float* out;
  unsigned char* ws;
  int ph_lo, ph_hi;
};

typedef __bf16 hbf2 __attribute__((ext_vector_type(2)));
typedef float f32x2 __attribute__((ext_vector_type(2)));
DEV bf16 f2bf(float f) { __bf16 h = (__bf16)f; return *(bf16*)&h; }
DEV float bf2f(bf16 h) { return __uint_as_float(((unsigned)h) << 16); }
DEV unsigned pack2(float a, float b) { f32x2 v = {a, b}; hbf2 r = __builtin_convertvector(v, hbf2); return *(unsigned*)&r; }
DEV int ltid() { int t = threadIdx.x; asm volatile("" : "+v"(t)); return t; }
DEV float wave_sum(float v) {
#pragma unroll
  for (int o = 32; o > 0; o >>= 1) v += __shfl_xor(v, o);
  return v;
}
DEV float quad_max(float x) {
  unsigned u = __float_as_uint(x);
  auto r = __builtin_amdgcn_permlane32_swap(u, u, false, false);
  const float a = fmaxf(__uint_as_float(r[0]), __uint_as_float(r[1]));
  const unsigned ua = __float_as_uint(a);
  auto r2 = __builtin_amdgcn_permlane16_swap(ua, ua, false, false);
  return fmaxf(__uint_as_float(r2[0]), __uint_as_float(r2[1]));
}
DEV float quad_sum(float x) {
  unsigned u = __float_as_uint(x);
  auto r = __builtin_amdgcn_permlane32_swap(u, u, false, false);
  const float a = __uint_as_float(r[0]) + __uint_as_float(r[1]);
  const unsigned ua = __float_as_uint(a);
  auto r2 = __builtin_amdgcn_permlane16_swap(ua, ua, false, false);
  return __uint_as_float(r2[0]) + __uint_as_float(r2[1]);
}
struct RowInfo { int b, t, L, mi, tall, sbase; bool ctx; };
DEV RowInfo rowinfo(int row) {
  RowInfo r; r.ctx = row >= NLAT;
  if (r.ctx) { int q = row - NLAT; r.b = q >> 8; r.t = q & 255; r.L = CTX; r.mi = 4; r.tall = r.t; r.sbase = row - r.t; }
  else { r.b = row >> 13; r.t = row & 8191; r.L = SEQ; r.mi = r.b; r.tall = CTX + r.t; r.sbase = row - r.t; }
  return r;
}

DEV int swz4(int x) { return (0x1320 >> (x * 4)) & 3; }
template <int MT, bool SW>
DEV void gemm_mainloop(f32x4 (&acc)[MT][4], const bf16* A, size_t lda, unsigned amask, const bf16* zsrc, const bf16* B, size_t ldb, int K, unsigned char* smem) {
  constexpr int ABYTES = 32 * MT * 64, GST = ABYTES + 8192, NA = MT / 2;
  const int tid = ltid(), lane = tid & 63, wid = tid >> 6, wr = wid >> 1, wc = wid & 1, fr = lane & 15, fq = lane >> 4;
  const int r0 = tid >> 2, gch = (tid & 3) ^ swz4((tid >> 4) & 3);
  const bf16* ga[NA]; int ia[NA];
#pragma unroll
  for (int i = 0; i < NA; ++i) {
    const bool ok = (amask >> i) & 1u;
    ga[i] = ok ? (A + (size_t)(r0 + 64 * i) * lda + gch * 8) : zsrc; ia[i] = ok ? 32 : 0;
  }
  const bf16* gb0 = B + (size_t)r0 * ldb + gch * 8;
  const bf16* gb1 = B + (size_t)(r0 + 64) * ldb + gch * 8;
  unsigned char* ldst = smem + tid * 16;
#define GLDS(stg) do { unsigned char* d_ = ldst + (stg) * GST; \
    _Pragma("unroll") for (int i_ = 0; i_ < NA; ++i_) { __builtin_amdgcn_global_load_lds((const unsigned*)ga[i_], (unsigned*)(d_ + i_ * 4096), 16, 0, 0); ga[i_] += ia[i_]; } \
    __builtin_amdgcn_global_load_lds((const unsigned*)gb0, (unsigned*)(d_ + ABYTES), 16, 0, 0); \
    __builtin_amdgcn_global_load_lds((const unsigned*)gb1, (unsigned*)(d_ + ABYTES + 4096), 16, 0, 0); \
    gb0 += 32; gb1 += 32; } while (0)
  const int rd_a = (wr * 16 * MT + fr) * 64 + ((fq ^ swz4(fr >> 2)) << 4);
  const int rd_b = ABYTES + (wc * 64 + fr) * 64 + ((fq ^ swz4(fr >> 2)) << 4);
  const int nt = K >> 5;
  asm volatile("s_waitcnt vmcnt(0)" ::: "memory");
  GLDS(0);
  if (nt > 1) GLDS(1);
  int st = 0, st2 = 2;
  for (int t = 0; t < nt; ++t) {
    if (t + 1 < nt) { if (MT == 8) asm volatile("s_waitcnt vmcnt(6) lgkmcnt(0)" ::: "memory"); else asm volatile("s_waitcnt vmcnt(4) lgkmcnt(0)" ::: "memory"); }
    else asm volatile("s_waitcnt vmcnt(0) lgkmcnt(0)" ::: "memory");
    __builtin_amdgcn_s_barrier();
    asm volatile("" ::: "memory");
    if (t + 2 < nt) GLDS(st2);
    const unsigned char* s = smem + st * GST;
    bf16x8 bfr[4];
#pragma unroll
    for (int n = 0; n < 4; ++n) bfr[n] = *(const bf16x8*)(s + rd_b + n * 1024);
#pragma unroll
    for (int mh = 0; mh < MT; mh += 4) {
      bf16x8 af[4];
#pragma unroll
      for (int m = 0; m < 4; ++m) af[m] = *(const bf16x8*)(s + rd_a + (mh + m) * 1024);
#pragma unroll
      for (int m = 0; m < 4; ++m)
#pragma unroll
        for (int n = 0; n < 4; ++n)
          acc[mh + m][n] = SW ? __builtin_amdgcn_mfma_f32_16x16x32_bf16(bfr[n], af[m], acc[mh + m][n], 0, 0, 0)
                              : __builtin_amdgcn_mfma_f32_16x16x32_bf16(af[m], bfr[n], acc[mh + m][n], 0, 0, 0);
    }
    st = (st == 2) ? 0 : st + 1; st2 = (st2 == 2) ? 0 : st2 + 1;
  }
#undef GLDS
  __syncthreads();
}

#define TILE_IDS \
  const int tid = ltid(), lane = tid & 63, wid = tid >> 6, wr = wid >> 1, wc = wid & 1, fr = lane & 15, fq = lane >> 4; \
  const int lrow = tid >> 3, lch = tid & 7; (void)lane; (void)wr; (void)wc; (void)fr; (void)fq; (void)lrow; (void)lch;

template <int MT>
DEV void zero_acc(f32x4 (&acc)[MT][4]) {
#pragma unroll
  for (int m = 0; m < MT; ++m)
#pragma unroll
    for (int n = 0; n < 4; ++n) acc[m][n] = f32x4{0.f, 0.f, 0.f, 0.f};
}

template <int MT, bool TR, typename AF>
DEV void epi_store(const f32x4 (&acc)[MT][4], unsigned char* smem, AF addr) {
  const int tid = ltid(), lane = tid & 63, wid = tid >> 6, wr = wid >> 1, wc = wid & 1, fr = lane & 15, fq = lane >> 4;
  constexpr int LD = 136;
  bf16* sC = (bf16*)smem;
#pragma unroll
  for (int m = 0; m < MT; ++m)
#pragma unroll
    for (int n = 0; n < 4; ++n) {
      uint2 o; o.x = pack2(acc[m][n][0], acc[m][n][1]); o.y = pack2(acc[m][n][2], acc[m][n][3]);
      if (TR) *(uint2*)(sC + (wc * 64 + n * 16 + fr) * LD + wr * 64 + m * 16 + fq * 4) = o;
      else *(uint2*)(sC + (wr * 16 * MT + m * 16 + fr) * LD + wc * 64 + n * 16 + fq * 4) = o;
    }
  __syncthreads();
#pragma unroll
  for (int i = 0; i < 2 * MT; ++i) {
    const int idx = tid + 256 * i, r = idx >> 4, ch = idx & 15;
    bf16* g = addr(r, ch);
    if (g) *(uint4*)g = *(const uint4*)(sC + r * LD + ch * 8);
  }
  __syncthreads();
}

DEV void wprep_tile(const float* src, int ld, int nvalid, const float* kscale, bf16* dst, int K, int k0, unsigned char* smem) {
  bf16* sT = (bf16*)smem;
  const int tid = ltid();
  {
    const int nn = (tid & 15) * 4;
#pragma unroll
    for (int i = 0; i < 4; ++i) {
      const int kk = (tid >> 4) + 16 * i;
      float4 v = make_float4(0.f, 0.f, 0.f, 0.f);
      if (nn < nvalid) v = *(const float4*)(src + (size_t)(k0 + kk) * ld + nn);
      if (kscale) { const float ks = kscale[k0 + kk]; v.x *= ks; v.y *= ks; v.z *= ks; v.w *= ks; }
      sT[(nn + 0) * 66 + kk] = f2bf(v.x); sT[(nn + 1) * 66 + kk] = f2bf(v.y);
      sT[(nn + 2) * 66 + kk] = f2bf(v.z); sT[(nn + 3) * 66 + kk] = f2bf(v.w);
    }
  }
  __syncthreads();
  {
    const int kk2 = (tid & 31) * 2;
#pragma unroll
    for (int i = 0; i < 8; ++i) {
      const int nn = (tid >> 5) + 8 * i;
      const unsigned v = *(const unsigned*)(sT + nn * 66 + kk2);
      *(unsigned*)(dst + (size_t)nn * K + k0 + kk2) = v;
    }
  }
  __syncthreads();
}

constexpr int WP_TILES_L = 736 + 768 + 96 + 64 + 384 + 256 + 1408 + 704 + 16;
constexpr int MOD_ITEMS = 2 * 96;

DEV void phase_prep(const Params& p, unsigned char* smem) {
  const int tid = ltid();
  const int nitems = 2 * WP_TILES_L + MOD_ITEMS;
  for (int it = blockIdx.x; it < nitems; it += gridDim.x) {
    if (it < MOD_ITEMS) {
      const int l = it / 96, n0 = (it % 96) * 64;
      float* sC = (float*)smem;
      float* sRed = (float*)(smem + 5 * 1024 * 4);
      for (int e = tid; e < 5 * 1024; e += 256) {
        const int v = e >> 10, k = e & 1023;
        const float c = (v < 4) ? p.in[1][v * 1024 + k] : p.in[3][k];
        sC[e] = c / (1.f + __expf(-c));
      }
      __syncthreads();
      const int w = tid >> 6, ln = tid & 63, kq = ln >> 4, n4 = (ln & 15) * 4;
      float a[5][4];
#pragma unroll
      for (int v = 0; v < 5; ++v) { a[v][0] = 0.f; a[v][1] = 0.f; a[v][2] = 0.f; a[v][3] = 0.f; }
      const float* wa = p.in[4] + (size_t)l * 1024 * 6144 + n0 + n4;
#pragma unroll 4
      for (int i = 0; i < 64; ++i) {
        const int k = w * 256 + i * 4 + kq;
        const float4 wv = *(const float4*)(wa + (size_t)k * 6144);
#pragma unroll
        for (int v = 0; v < 5; ++v) { const float c = sC[v * 1024 + k]; a[v][0] += c * wv.x; a[v][1] += c * wv.y; a[v][2] += c * wv.z; a[v][3] += c * wv.w; }
      }
#pragma unroll
      for (int v = 0; v < 5; ++v) *(float4*)(sRed + ((w * 4 + kq) * 5 + v) * 64 + n4) = make_float4(a[v][0], a[v][1], a[v][2], a[v][3]);
      __syncthreads();
      for (int e = tid; e < 5 * 64; e += 256) {
        const int v = e >> 6, nn = e & 63;
        float sacc = 0.f;
#pragma unroll
        for (int part = 0; part < 16; ++part) sacc += sRed[(part * 5 + v) * 64 + nn];
        ((float*)(p.ws + WS_MOD))[(size_t)(l * 5 + v) * 6144 + n0 + nn] = sacc + p.in[5][l * 6144 + n0 + nn];
      }
      __syncthreads();
    } else {
      int q = it - MOD_ITEMS;
      const int l = q / WP_TILES_L; q -= l * WP_TILES_L;
      unsigned char* wl = p.ws + WS_W + (size_t)l * SZ_WL;
      const float* src; int ld, K, nvalid = 64; const float* ksc = nullptr; bf16* dst; int nc, kc;
      if (q < 736) {
        nc = q / 16; kc = q % 16; K = 1024; ld = INC; src = p.in[10] + (size_t)l * 1024 * INC + nc * 64;
        nvalid = 2848 - nc * 64; dst = (bf16*)(wl + O_WIN) + (size_t)nc * 64 * K;
      } else if ((q -= 736) < 768) {
        nc = q / 16; kc = q % 16; K = 1024; ld = INC; src = p.in[10] + (size_t)l * 1024 * INC + 2848 + nc * 64;
        dst = (bf16*)(wl + O_WG) + (size_t)nc * 64 * K;
      } else if ((q -= 768) < 96) {
        nc = q / 8; kc = q % 8; K = 512; ld = 768; src = p.in[15] + (size_t)l * 512 * 768 + nc * 64; ksc = p.in[14] + l * 512;
        dst = (bf16*)(wl + O_WUQ) + (size_t)nc * 64 * K;
      } else if ((q -= 96) < 64) {
        nc = q / 4; kc = q % 4; K = 256; ld = 1024; ksc = p.in[16] + l * 256;
        src = p.in[17] + (size_t)l * 256 * 1024 + ((nc < 8) ? nc * 128 : (nc - 8) * 128 + 64);
        dst = (bf16*)(wl + O_WUKV) + (size_t)nc * 64 * K;
      } else if ((q -= 64) < 384) {
        const int k3 = q / 128; const int r = q % 128; nc = r / 8; kc = r % 8; K = 512; ld = 1024;
        src = p.in[18] + ((size_t)l * 3 + k3) * 512 * 1024 + nc * 64; dst = (bf16*)(wl + O_WBR) + (size_t)k3 * 1024 * 512 + (size_t)nc * 64 * K;
      } else if ((q -= 384) < 256) {
        nc = q / 16; kc = q % 16; K = 1024; ld = 1024; src = p.in[19] + (size_t)l * 1024 * 1024 + nc * 64; dst = (bf16*)(wl + O_WO) + (size_t)nc * 64 * K;
      } else if ((q -= 256) < 1408) {
        nc = q / 16; kc = q % 16; K = 1024; ld = 2 * DFF;
        const int scol = (nc & 1) ? (DFF + (nc >> 1) * 64) : ((nc >> 1) * 64);
        src = p.in[20] + (size_t)l * 1024 * 2 * DFF + scol; dst = (bf16*)(wl + O_WUP) + (size_t)nc * 64 * K;
      } else if ((q -= 1408) < 704) {
        nc = q / 44; kc = q % 44; K = DFF; ld = 1024; src = p.in[23] + (size_t)l * DFF * 1024 + nc * 64; dst = (bf16*)(wl + O_WDN) + (size_t)nc * 64 * K;
      } else {
        q -= 704; const int g = q >> 2, r = q & 3; nc = r >> 1; kc = r & 1; K = 128; ld = 128;
        src = p.in[12] + ((size_t)l * 4 + g) * 128 * 128 + nc * 64; dst = (bf16*)(wl + O_WPL) + (size_t)g * 128 * 128 + (size_t)nc * 64 * K;
      }
      wprep_tile(src, ld, nvalid, ksc, dst, K, kc * 64, smem);
    }
  }
}

struct RowRegs { float4 x[4]; uint2 y[4]; };
DEV void row_load(RowRegs& r, const float* xin, const bf16* y) {
  const int lane = ltid() & 63;
#pragma unroll
  for (int i = 0; i < 4; ++i) r.x[i] = *(const float4*)(xin + i * 256 + lane * 4);
  if (y) {
#pragma unroll
    for (int i = 0; i < 4; ++i) r.y[i] = *(const uint2*)(y + i * 256 + lane * 4);
  }
}
DEV void row_finish(RowRegs& r, bool has_y, const float* gate, const float* gpost, float* xout,
                    const float* gpre, const float* shift, const float* scale, bf16* hout) {
  const int lane = ltid() & 63;
  float4 (&xv)[4] = r.x;
  if (has_y) {
    float yv[4][4]; float ss = 0.f;
#pragma unroll
    for (int i = 0; i < 4; ++i) {
      const uint2 u = r.y[i];
      yv[i][0] = __uint_as_float(u.x << 16); yv[i][1] = __uint_as_float(u.x & 0xffff0000u);
      yv[i][2] = __uint_as_float(u.y << 16); yv[i][3] = __uint_as_float(u.y & 0xffff0000u);
#pragma unroll
      for (int j = 0; j < 4; ++j) ss += yv[i][j] * yv[i][j];
    }
    ss = wave_sum(ss);
    const float rs = rsqrtf(ss * (1.f / 1024.f) + EPS);
#pragma unroll
    for (int i = 0; i < 4; ++i) {
      const float4 g = *(const float4*)(gate + i * 256 + lane * 4);
      const float4 gp = *(const float4*)(gpost + i * 256 + lane * 4);
      xv[i].x += g.x * (yv[i][0] * rs * gp.x); xv[i].y += g.y * (yv[i][1] * rs * gp.y);
      xv[i].z += g.z * (yv[i][2] * rs * gp.z); xv[i].w += g.w * (yv[i][3] * rs * gp.w);
    }
  }
  if (xout) {
#pragma unroll
    for (int i = 0; i < 4; ++i) *(float4*)(xout + i * 256 + lane * 4) = xv[i];
  }
  if (hout) {
    float ss = 0.f;
#pragma unroll
    for (int i = 0; i < 4; ++i) ss += xv[i].x * xv[i].x + xv[i].y * xv[i].y + xv[i].z * xv[i].z + xv[i].w * xv[i].w;
    ss = wave_sum(ss);
    const float rs = rsqrtf(ss * (1.f / 1024.f) + EPS);
#pragma unroll
    for (int i = 0; i < 4; ++i) {
      const float4 gp = *(const float4*)(gpre + i * 256 + lane * 4);
      const float4 sh = *(const float4*)(shift + i * 256 + lane * 4);
      const float4 sc = *(const float4*)(scale + i * 256 + lane * 4);
      const float h0 = xv[i].x * rs * gp.x * (1.f + sc.x) + sh.x, h1 = xv[i].y * rs * gp.y * (1.f + sc.y) + sh.y;
      const float h2 = xv[i].z * rs * gp.z * (1.f + sc.z) + sh.z, h3 = xv[i].w * rs * gp.w * (1.f + sc.w) + sh.w;
      uint2 o; o.x = pack2(h0, h1); o.y = pack2(h2, h3);
      *(uint2*)(hout + i * 256 + lane * 4) = o;
    }
  }
}

DEV void phase_rows(const Params& p, int l, int kind, int nrows) {
  const int wid = ltid() >> 6;
  const float* MOD = (const float*)(p.ws + WS_MOD);
  float* XC = (float*)(p.ws + WS_XC);
  bf16* H = (bf16*)(p.ws + WS_H);
  const bf16* Y = (const bf16*)(p.ws + WS_Y);
  const int nitems = nrows / 16;
  const bool from_input = (l == 0 && kind <= 1);
  for (int it = blockIdx.x; it < nitems; it += gridDim.x) {
    const int rbase = it * 16 + wid * 4;
    const RowInfo ri = rowinfo(rbase);
    const float* xin0 = ri.ctx ? ((from_input ? p.in[2] : XC) + (size_t)(rbase - NLAT) * D) : ((from_input ? p.in[0] : p.out) + (size_t)rbase * D);
    float* xout0 = ri.ctx ? (XC + (size_t)(rbase - NLAT) * D) : (p.out + (size_t)rbase * D);
    const float* mod = MOD + (size_t)(l * 5 + ri.mi) * 6144;
    const float* mod2 = MOD + (size_t)((l + 1) * 5 + ri.mi) * 6144;
    const bf16* y0 = (kind == 0) ? nullptr : (Y + (size_t)rbase * D);
    bf16* h0 = H + (size_t)rbase * D;
    {
      RowRegs rr[4];
#pragma unroll
      for (int e = 0; e < 4; ++e) row_load(rr[e], xin0 + (size_t)e * D, y0 ? y0 + (size_t)e * D : nullptr);
#pragma unroll
      for (int e = 0; e < 4; ++e) {
        const size_t off = (size_t)e * D;
        if (kind == 0) row_finish(rr[e], false, nullptr, nullptr, nullptr, p.in[6] + l * D, mod, mod + 1024, h0 + off);
        else if (kind == 1) row_finish(rr[e], true, mod + 2048, p.in[7] + l * D, xout0 + off, p.in[8] + l * D, mod + 3072, mod + 4096, h0 + off);
        else row_finish(rr[e], true, mod + 5120, p.in[9] + l * D, xout0 + off, p.in[6] + (l + 1) * D, mod2, mod2 + 1024, (l == 0) ? (h0 + off) : nullptr);
      }
    }
  }
}

DEV void phase_inproj(const Params& p, int l, unsigned char* smem) {
  const int tid = ltid(), lane = tid & 63, wid = tid >> 6, wr = wid >> 1, wc = wid & 1, fr = lane & 15, fq = lane >> 4;
  const bf16* H = (const bf16*)(p.ws + WS_H);
  const bf16* W = (const bf16*)(p.ws + WS_W + (size_t)l * SZ_WL + O_WIN);
  bf16* NAQ = (bf16*)(p.ws + WS_NAQ); bf16* NAK = (bf16*)(p.ws + WS_NAK); bf16* NAVT = (bf16*)(p.ws + WS_NAVT);
  bf16* POOLU = (bf16*)(p.ws + WS_POOLU); bf16* CQ = (bf16*)(p.ws + WS_CQ); bf16* CKV = (bf16*)(p.ws + WS_CKV);
  float* KR = (float*)(p.ws + WS_KR);
  const int nmain = 8 * 2 * 19 * 8, nbig = nmain + 4 * 19, nitems = nbig + 264 * 4;
  for (int it = blockIdx.x; it < nitems; it += gridDim.x) {
    if (it < nbig) {
      int mt, j;
      if (it < nmain) { const int xq = it & 7, jq = it >> 3, ml = jq & 7, jn = jq >> 3; j = jn % 19; mt = ((jn / 19) * 8 + ml) * 8 + xq; }
      else { const int q = it - nmain; mt = 128 + q / 19; j = q % 19; }
      const int ntile = (j < 8) ? j : j + 4, row0 = mt * 256, n0 = ntile * 128;
      f32x4 acc[8][4]; zero_acc<8>(acc);
      gemm_mainloop<8, true>(acc, H + (size_t)row0 * D, D, 15u, nullptr, W + (size_t)n0 * 1024, 1024, 1024, smem);
      if (ntile == 22) {
#pragma unroll
        for (int m = 0; m < 8; ++m)
#pragma unroll
          for (int n = 0; n < 4; ++n) {
            const int col = wc * 64 + n * 16 + fq * 4, row = row0 + wr * 128 + m * 16 + fr;
            if (col < 32) *(float4*)(KR + (size_t)row * 32 + col) = make_float4(acc[m][n][0], acc[m][n][1], acc[m][n][2], acc[m][n][3]);
          }
        __syncthreads();
      } else {
        bf16* dst; int ld, c0 = n0 & 511;
        if (ntile < 4) {
          dst = NAQ; ld = 512;
          const float sc = 0.125f * 1.4426950408889634f;
#pragma unroll
          for (int m = 0; m < 8; ++m)
#pragma unroll
            for (int n = 0; n < 4; ++n) acc[m][n] *= sc;
        } else if (ntile < 8) { dst = NAK; ld = 512; }
        else if (ntile < 16) { dst = POOLU; ld = 512; }
        else if (ntile < 20) { dst = CQ; ld = 512; }
        else { dst = CKV; ld = 256; c0 = n0 - 2560; }
        bf16* db = dst + (size_t)row0 * ld + c0;
        epi_store<8, false>(acc, smem, [=](int r, int ch) -> bf16* { return db + (size_t)r * ld + ch * 8; });
      }
    } else {
      const int q = it - nbig, mt = q >> 2, ntile = 8 + (q & 3), row0 = mt * 128, n0 = ntile * 128;
      const RowInfo r0 = rowinfo(row0);
      f32x4 acc[4][4]; zero_acc<4>(acc);
      gemm_mainloop<4, false>(acc, H + (size_t)row0 * D, D, 3u, nullptr, W + (size_t)n0 * 1024, 1024, 1024, smem);
      const int c0 = n0 - 1024;
      bf16* vb = NAVT + (size_t)r0.b * 8 * 64 * TALL + r0.tall;
      epi_store<4, true>(acc, smem, [=](int cl, int ch) -> bf16* { return vb + (size_t)(c0 + cl) * TALL + ch * 8; });
    }
  }
}

DEV float rope_inv(int f) {
  const float tb[8] = {1.f, 0.316227766f, 0.1f, 0.0316227766f, 0.01f, 0.00316227766f, 0.001f, 0.000316227766f};
  float r = tb[0];
#pragma unroll
  for (int i = 1; i < 8; ++i) r = (f == i) ? tb[i] : r;
  return r;
}

template <int HW>
DEV void pool_diff16(const bf16* ub, bf16* db, int t0, int L) {
  constexpr int NR = 16 + 2 * HW - 1;
  float v0[NR], v1[NR];
#pragma unroll
  for (int i = 0; i < NR; ++i) {
    const int t = t0 - HW + i;
    const bool ok = (t >= 0) && (t < L);
    const unsigned u = *(const unsigned*)(ub + (size_t)(ok ? t : t0) * 512);
    v0[i] = ok ? __uint_as_float(u << 16) : 0.f; v1[i] = ok ? __uint_as_float(u & 0xffff0000u) : 0.f;
  }
#pragma unroll
  for (int rr = 0; rr < 16; ++rr) {
    float s0 = 0.f, s1 = 0.f;
#pragma unroll
    for (int k = 0; k < 2 * HW; ++k) { s0 += v0[rr + k]; s1 += v1[rr + k]; }
    const int t = t0 + rr;
    const float inv = 1.f / (float)(min(t + HW, L) - max(t - HW, 0));
    *(unsigned*)(db + (size_t)rr * 512) = pack2(s0 * inv - v0[rr + HW], s1 * inv - v1[rr + HW]);
  }
}

DEV void phase_mlaproj(const Params& p, int l, unsigned char* smem) {
  TILE_IDS
  const bf16* CQ = (const bf16*)(p.ws + WS_CQ); const bf16* CKV = (const bf16*)(p.ws + WS_CKV);
  const float* KR = (const float*)(p.ws + WS_KR);
  const bf16* POOLU = (const bf16*)(p.ws + WS_POOLU); bf16* POOLD = (bf16*)(p.ws + WS_POOLD);
  bf16* QF = (bf16*)(p.ws + WS_QF); bf16* KF = (bf16*)(p.ws + WS_KF); bf16* VT = (bf16*)(p.ws + WS_VT);
  const bf16* WUQ = (const bf16*)(p.ws + WS_W + (size_t)l * SZ_WL + O_WUQ);
  const bf16* WUKV = (const bf16*)(p.ws + WS_W + (size_t)l * SZ_WL + O_WUKV);
  float* sR = (float*)(smem + LDS_GEMM);
  constexpr int N_UQ = 264 * 6, N_UKV = 264 * 8, N_ROPE = 264, N_PD = MT / 16;
  const int nitems = N_UQ + N_UKV + N_ROPE + N_PD;
  const float QSCALE = 0.10206207261596575f * 1.4426950408889634f;
  for (int it = blockIdx.x; it < nitems; it += gridDim.x) {
    if (it < N_UQ + N_UKV) {
      const bool isq = it < N_UQ;
      const int q = isq ? it : it - N_UQ;
      const int xq = q & 7, jq = q >> 3;
      const int mt = (isq ? jq / 6 : jq >> 3) * 8 + xq, ntile = isq ? jq % 6 : jq & 7, row0 = mt * 128, n0 = ntile * 128;
      const int KD = isq ? 512 : 256;
      const bf16* A = isq ? CQ : CKV; const bf16* W = isq ? WUQ : WUKV;
      {
        const int rl = tid >> 1, half = tid & 1;
        const bf16* rp = A + (size_t)(row0 + rl) * KD + half * (KD / 2);
        float ss = 0.f;
        for (int i = 0; i < KD / 16; ++i) {
          const uint4 v = *(const uint4*)(rp + i * 8);
          const unsigned uu[4] = {v.x, v.y, v.z, v.w};
#pragma unroll
          for (int e = 0; e < 4; ++e) { const float a = __uint_as_float(uu[e] << 16), b = __uint_as_float(uu[e] & 0xffff0000u); ss += a * a + b * b; }
        }
        ss += __shfl_xor(ss, 1);
        if (!half) sR[rl] = rsqrtf(ss / (float)KD + EPS);
      }
      f32x4 acc[4][4]; zero_acc<4>(acc);
      const bf16* a0 = A + (size_t)row0 * KD;
      const bf16* b0 = W + (size_t)n0 * KD;
      const RowInfo r0 = rowinfo(row0);
      if (isq) {
        gemm_mainloop<4, true>(acc, a0, KD, 3u, nullptr, b0, KD, KD, smem);
#pragma unroll
        for (int m = 0; m < 4; ++m) {
          const int rl = wr * 64 + m * 16 + fr, t = r0.t + rl;
          const float rs = sR[rl] * QSCALE;
#pragma unroll
          for (int n = 0; n < 4; ++n) {
            const int colb = n0 + wc * 64 + n * 16;
            const int h = colb / 96, cb = colb - h * 96;
#pragma unroll
            for (int j = 0; j < 4; ++j) {
              float v = acc[m][n][j] * rs;
              const float pv = __shfl_xor(v, 32);
              if (cb >= 64 && !r0.ctx) {
                const int hf = (cb - 64) >> 4, ii = fq * 4 + j, f = ii & 7;
                const float pos = (float)(hf ? (t & 63) : (t >> 6));
                float sn, cs; __sincosf(pos * rope_inv(f), &sn, &cs);
                v = (ii >> 3) ? (pv * sn + v * cs) : (v * cs - pv * sn);
              }
              acc[m][n][j] = v;
            }
          }
        }
        bf16* db = QF + (size_t)row0 * 768 + n0;
        epi_store<4, false>(acc, smem, [=](int r, int ch) -> bf16* { return db + (size_t)r * 768 + ch * 8; });
      } else if (ntile < 4) {
        gemm_mainloop<4, true>(acc, a0, KD, 3u, nullptr, b0, KD, KD, smem);
#pragma unroll
        for (int m = 0; m < 4; ++m) {
          const float rs = sR[wr * 64 + m * 16 + fr];
#pragma unroll
          for (int n = 0; n < 4; ++n) acc[m][n] *= rs;
        }
        bf16* kb = KF + ((size_t)(r0.b * 8 + 2 * ntile) * TALL + r0.tall) * 96;
        epi_store<4, false>(acc, smem, [=](int r, int ch) -> bf16* { return kb + ((size_t)(ch >> 3) * TALL + r) * 96 + (ch & 7) * 8; });
      } else {
        gemm_mainloop<4, false>(acc, a0, KD, 3u, nullptr, b0, KD, KD, smem);
#pragma unroll
        for (int m = 0; m < 4; ++m)
#pragma unroll
          for (int j = 0; j < 4; ++j) {
            const float rs = sR[wr * 64 + m * 16 + fq * 4 + j];
#pragma unroll
            for (int n = 0; n < 4; ++n) acc[m][n][j] *= rs;
          }
        bf16* vb = VT + (size_t)(r0.b * 8 + 2 * (ntile - 4)) * 64 * TALL + r0.tall;
        epi_store<4, true>(acc, smem, [=](int cl, int ch) -> bf16* { return vb + (size_t)cl * TALL + ch * 8; });
      }
    } else if (it < N_UQ + N_UKV + N_ROPE) {
      const int row0 = (it - N_UQ - N_UKV) * 128;
      for (int e = tid; e < 128 * 16; e += 256) {
        const int rl = e >> 4, pp = e & 15, hf = pp >> 3, f = pp & 7, row = row0 + rl;
        const RowInfo ri = rowinfo(row);
        const float x1 = KR[(size_t)row * 32 + hf * 16 + f], x2 = KR[(size_t)row * 32 + hf * 16 + 8 + f];
        float o1 = x1, o2 = x2;
        if (!ri.ctx) {
          const float pos = (float)(hf ? (ri.t & 63) : (ri.t >> 6));
          float sn, cs; __sincosf(pos * rope_inv(f), &sn, &cs);
          o1 = x1 * cs - x2 * sn; o2 = x1 * sn + x2 * cs;
        }
        const bf16 b1 = f2bf(o1), b2 = f2bf(o2);
#pragma unroll
        for (int h = 0; h < 8; ++h) {
          bf16* kd = KF + ((size_t)(ri.b * 8 + h) * TALL + ri.tall) * 96 + 64 + hf * 16 + f;
          kd[0] = b1; kd[8] = b2;
        }
      }
    } else {
      const int row0 = (it - N_UQ - N_UKV - N_ROPE) * 16;
      const int ch = tid * 2, g = ch >> 7;
      const RowInfo r0 = rowinfo(row0);
      const bf16* ub = POOLU + (size_t)r0.sbase * 512 + ch;
      bf16* db = POOLD + (size_t)row0 * 512 + ch;
      if (g == 0) pool_diff16<1>(ub, db, r0.t, r0.L);
      else if (g == 1) pool_diff16<2>(ub, db, r0.t, r0.L);
      else if (g == 2) pool_diff16<4>(ub, db, r0.t, r0.L);
      else pool_diff16<8>(ub, db, r0.t, r0.L);
    }
  }
}

struct FlashDesc {
  const bf16* q; int qstride;
  bf16* o; int ostride;
  const bf16* kwin; const bf16* kseq; int kstride;
  const bf16* vbase;
  int nwin, r0a, nchunks;
  int qr0;
  const float* rpb;
};

template <int DQK>
DEV void flash_unit(const FlashDesc& fd, unsigned char* smem) {
  constexpr int NKP = DQK / 32, KBYTES = NKP * 4096, STAGE = KBYTES + 8192, NKS = DQK / 32;
  const int tid = ltid(), lane = tid & 63, w = tid >> 6, fr = lane & 15, fq = lane >> 4;
  float* sRpb = (float*)(smem + 3 * STAGE);
  if (fd.nwin > 0) { for (int e = tid; e < 465; e += 256) sRpb[e] = fd.rpb[e] * 1.4426950408889634f; }
  bf16x8 qf[2][NKS];
#pragma unroll
  for (int nt = 0; nt < 2; ++nt)
#pragma unroll
    for (int ks = 0; ks < NKS; ++ks) qf[nt][ks] = *(const bf16x8*)(fd.q + (size_t)(w * 32 + nt * 16 + fr) * fd.qstride + ks * 32 + fq * 8);
  f32x4 O[4][2];
#pragma unroll
  for (int m = 0; m < 4; ++m) { O[m][0] = f32x4{0.f, 0.f, 0.f, 0.f}; O[m][1] = f32x4{0.f, 0.f, 0.f, 0.f}; }
  float mrun[2] = {0.f, 0.f};
  f32x4 Lacc[2] = {f32x4{0.f, 0.f, 0.f, 0.f}, f32x4{0.f, 0.f, 0.f, 0.f}};
  bf16x8 ones; { union { uint4 u; bf16x8 b; } cv; cv.u = make_uint4(0x3F803F80u, 0x3F803F80u, 0x3F803F80u, 0x3F803F80u); ones = cv.b; }
  bool first = true;
  const int srow = tid >> 2, sch = (tid & 3) ^ swz4((tid >> 4) & 3);
  const int skey = ((srow >> 5) * 32) + (((srow >> 2) & 3) * 8) + (((srow >> 4) & 1) * 4) + (srow & 3);
  const size_t koff = (size_t)skey * fd.kstride + sch * 8, voff = (size_t)srow * TALL + sch * 8;
  unsigned char* ldst = smem + tid * 16;
#define F_GLDS(c_, stg_) do { const int c__ = (c_); const bf16* kp; const bf16* vp; \
    if (c__ < fd.nwin) { const int kr = fd.r0a + c__; kp = fd.kwin + (size_t)kr * 64 * fd.kstride; vp = fd.vbase + CTX + kr * 64; } \
    else { const int cc = c__ - fd.nwin; kp = fd.kseq + (size_t)cc * 64 * fd.kstride; vp = fd.vbase + cc * 64; } \
    unsigned char* d_ = ldst + (stg_) * STAGE; \
    _Pragma("unroll") for (int p_ = 0; p_ < NKP; ++p_) __builtin_amdgcn_global_load_lds((const unsigned*)(kp + koff + p_ * 32), (unsigned*)(d_ + p_ * 4096), 16, 0, 0); \
    __builtin_amdgcn_global_load_lds((const unsigned*)(vp + voff), (unsigned*)(d_ + KBYTES), 16, 0, 0); \
    __builtin_amdgcn_global_load_lds((const unsigned*)(vp + voff + 32), (unsigned*)(d_ + KBYTES + 4096), 16, 0, 0); } while (0)
  const int rdo = fr * 64 + ((fq ^ swz4(fr >> 2)) << 4);
  const int nch = fd.nchunks;
  const int qr = fd.qr0 + (w >> 1);
  const int r0q = min(max(qr - 4, 0), 120);
  asm volatile("s_waitcnt vmcnt(0)" ::: "memory");
  F_GLDS(0, 0);
  if (nch > 1) F_GLDS(1, 1);
  int st = 0, st2 = 2;
  for (int c = 0; c < nch; ++c) {
    if (c + 1 < nch) { if (DQK == 96) asm volatile("s_waitcnt vmcnt(5) lgkmcnt(0)" ::: "memory"); else asm volatile("s_waitcnt vmcnt(4) lgkmcnt(0)" ::: "memory"); }
    else asm volatile("s_waitcnt vmcnt(0) lgkmcnt(0)" ::: "memory");
    __builtin_amdgcn_s_barrier();
    asm volatile("" ::: "memory");
    if (c + 2 < nch) F_GLDS(c + 2, st2);
    const unsigned char* s = smem + st * STAGE;
    st = (st == 2) ? 0 : st + 1; st2 = (st2 == 2) ? 0 : st2 + 1;
    const bool iswin = c < fd.nwin;
    const int keyrow = fd.r0a + c;
    const bool active = !iswin || (keyrow >= r0q && keyrow < r0q + 8);
    if (active) {
      f32x4 S[4][2];
      {
        const float c0 = first ? 0.f : -mrun[0], c1 = first ? 0.f : -mrun[1];
        const f32x4 ci0 = f32x4{c0, c0, c0, c0}, ci1 = f32x4{c1, c1, c1, c1};
        bf16x8 kf[4][NKS];
#pragma unroll
        for (int m = 0; m < 4; ++m)
#pragma unroll
          for (int ks = 0; ks < NKS; ++ks) kf[m][ks] = *(const bf16x8*)(s + ks * 4096 + m * 1024 + rdo);
#pragma unroll
        for (int m = 0; m < 4; ++m)
#pragma unroll
          for (int ks = 0; ks < NKS; ++ks) {
            S[m][0] = __builtin_amdgcn_mfma_f32_16x16x32_bf16(kf[m][ks], qf[0][ks], ks == 0 ? ci0 : S[m][0], 0, 0, 0);
            S[m][1] = __builtin_amdgcn_mfma_f32_16x16x32_bf16(kf[m][ks], qf[1][ks], ks == 0 ? ci1 : S[m][1], 0, 0, 0);
          }
      }
      bf16x8 vf[4][2];
#pragma unroll
      for (int m = 0; m < 4; ++m)
#pragma unroll
        for (int k2 = 0; k2 < 2; ++k2) {
          vf[m][k2] = *(const bf16x8*)(s + KBYTES + k2 * 4096 + m * 1024 + rdo);
        }
      if (iswin) {
        const float* brow = sRpb + (keyrow - qr + 7) * 31;
#pragma unroll
        for (int nt = 0; nt < 2; ++nt) {
          const int qc = (w & 1) * 32 + nt * 16 + fr;
          const int win0 = min(max(qc - 8, 0), 48);
#pragma unroll
          for (int m = 0; m < 4; ++m) {
            float bv[4];
#pragma unroll
            for (int j = 0; j < 4; ++j) bv[j] = brow[min(max((m >> 1) * 32 + fq * 8 + (m & 1) * 4 + j - qc + 15, 0), 30)];
#pragma unroll
            for (int j = 0; j < 4; ++j) {
              const int kc = (m >> 1) * 32 + fq * 8 + (m & 1) * 4 + j;
              const float sv = S[m][nt][j] + bv[j];
              S[m][nt][j] = ((kc >= win0) && (kc < win0 + 16)) ? sv : -1e30f;
            }
          }
        }
      }
      bf16x8 pf[2][2];
#pragma unroll
      for (int nt = 0; nt < 2; ++nt) {
        float mx = __builtin_fmaxf(__builtin_fmaxf(S[0][nt][0], S[0][nt][1]), S[0][nt][2]);
        mx = __builtin_fmaxf(__builtin_fmaxf(mx, S[0][nt][3]), S[1][nt][0]);
        mx = __builtin_fmaxf(__builtin_fmaxf(mx, S[1][nt][1]), S[1][nt][2]);
        mx = __builtin_fmaxf(__builtin_fmaxf(mx, S[1][nt][3]), S[2][nt][0]);
        mx = __builtin_fmaxf(__builtin_fmaxf(mx, S[2][nt][1]), S[2][nt][2]);
        mx = __builtin_fmaxf(__builtin_fmaxf(mx, S[2][nt][3]), S[3][nt][0]);
        mx = __builtin_fmaxf(__builtin_fmaxf(mx, S[3][nt][1]), S[3][nt][2]);
        mx = __builtin_fmaxf(mx, S[3][nt][3]);
        mx = quad_max(mx);
        if (first || __ballot(mx > 8.f) != 0ull) {
          const float dm = first ? mx : fmaxf(mx, 0.f);
          const float alpha = __builtin_amdgcn_exp2f(-dm);
          mrun[nt] += dm; Lacc[nt] *= alpha;
#pragma unroll
          for (int m = 0; m < 4; ++m) { O[m][nt] *= alpha; S[m][nt] -= dm; }
        }
        unsigned pu[4][2];
#pragma unroll
        for (int m = 0; m < 4; ++m) {
          const float e0 = __builtin_amdgcn_exp2f(S[m][nt][0]), e1 = __builtin_amdgcn_exp2f(S[m][nt][1]);
          const float e2 = __builtin_amdgcn_exp2f(S[m][nt][2]), e3 = __builtin_amdgcn_exp2f(S[m][nt][3]);
          pu[m][0] = pack2(e0, e1); pu[m][1] = pack2(e2, e3);
        }
#pragma unroll
        for (int k2 = 0; k2 < 2; ++k2) {
          union { uint4 u; bf16x8 b; } cv; cv.u = make_uint4(pu[2 * k2][0], pu[2 * k2][1], pu[2 * k2 + 1][0], pu[2 * k2 + 1][1]);
          pf[nt][k2] = cv.b;
        }
      }
#pragma unroll
      for (int m = 0; m < 4; ++m)
#pragma unroll
        for (int k2 = 0; k2 < 2; ++k2) {
          O[m][0] = __builtin_amdgcn_mfma_f32_16x16x32_bf16(vf[m][k2], pf[0][k2], O[m][0], 0, 0, 0);
          O[m][1] = __builtin_amdgcn_mfma_f32_16x16x32_bf16(vf[m][k2], pf[1][k2], O[m][1], 0, 0, 0);
        }
#pragma unroll
      for (int k2 = 0; k2 < 2; ++k2) {
        Lacc[0] = __builtin_amdgcn_mfma_f32_16x16x32_bf16(ones, pf[0][k2], Lacc[0], 0, 0, 0);
        Lacc[1] = __builtin_amdgcn_mfma_f32_16x16x32_bf16(ones, pf[1][k2], Lacc[1], 0, 0, 0);
      }
      first = false;
    }
  }
#pragma unroll
  for (int nt = 0; nt < 2; ++nt) {
    const float lt = Lacc[nt][0];
    const float il = 1.f / lt;
    bf16* op = fd.o + (size_t)(w * 32 + nt * 16 + fr) * fd.ostride + fq * 4;
#pragma unroll
    for (int m = 0; m < 4; ++m) {
      uint2 o; o.x = pack2(O[m][nt][0] * il, O[m][nt][1] * il); o.y = pack2(O[m][nt][2] * il, O[m][nt][3] * il);
      *(uint2*)(op + m * 16) = o;
    }
  }
  __syncthreads();
}

#ifndef MIXONLY
#define MIXONLY -1
#endif
#define MIXON(k) (MIXONLY == -1 || MIXONLY == (k))
DEV void phase_mixers(const Params& p, int l, unsigned char* smem) {
  TILE_IDS
  bf16* NAQ = (bf16*)(p.ws + WS_NAQ); const bf16* NAK = (const bf16*)(p.ws + WS_NAK); const bf16* NAVT = (const bf16*)(p.ws + WS_NAVT);
  const bf16* POOLD = (const bf16*)(p.ws + WS_POOLD); bf16* OPOOL = (bf16*)(p.ws + WS_POOLU); bf16* OMLA = (bf16*)(p.ws + WS_CQ);
  const bf16* QF = (const bf16*)(p.ws + WS_QF);
  const bf16* KF = (const bf16*)(p.ws + WS_KF); const bf16* VT = (const bf16*)(p.ws + WS_VT);
  const bf16* WPL = (const bf16*)(p.ws + WS_W + (size_t)l * SZ_WL + O_WPL);
  constexpr int N_MLA = 2048, N_NA = 2048;
  const int n_ctx = (l == 0) ? 128 : 0;
  const int n_flash = N_MLA + N_NA + n_ctx;
  const int n_pool = (l == 0 ? 264 : 256) * 4;
  const int nitems = n_flash + n_pool;
  for (int it = blockIdx.x; it < nitems; it += gridDim.x) {
    if (it < n_flash) {
      FlashDesc fd; fd.nwin = 0; fd.r0a = 0; fd.qr0 = 0; fd.rpb = nullptr; fd.kwin = nullptr; fd.ostride = 512;
      bool is96;
      if (it < N_MLA) {
        const int x = it & 7, slot = it >> 3, pair = (slot >> 6) * 8 + x, qb = slot & 63, b = pair >> 3, h = pair & 7;
        is96 = true;
        fd.q = QF + (size_t)(b * SEQ + qb * 128) * 768 + h * 96; fd.qstride = 768;
        fd.o = OMLA + (size_t)(b * SEQ + qb * 128) * 512 + h * 64;
        fd.kseq = KF + (size_t)pair * TALL * 96; fd.kstride = 96; fd.vbase = VT + (size_t)pair * 64 * TALL;
        fd.nchunks = TALL / 64;
      } else if (it < N_MLA + N_NA) {
        const int q = it - N_MLA, xq = q & 7, slot = q >> 3, pair = (slot >> 6) * 8 + xq, rp = slot & 63, b = pair >> 3, h = pair & 7, r = rp * 2;
        const int r0a = min(max(r - 4, 0), 120), r0b = min(max(r - 3, 0), 120);
        is96 = false;
        fd.q = NAQ + (size_t)(b * SEQ + r * 64) * 512 + h * 64; fd.qstride = 512; fd.o = NAQ + (size_t)(b * SEQ + r * 64) * 512 + h * 64;
        fd.kwin = NAK + (size_t)(b * SEQ) * 512 + h * 64; fd.kseq = NAK + (size_t)(NLAT + b * CTX) * 512 + h * 64; fd.kstride = 512;
        fd.vbase = NAVT + (size_t)pair * 64 * TALL;
        fd.nwin = r0b + 8 - r0a; fd.r0a = r0a; fd.nchunks = fd.nwin + 4; fd.qr0 = r;
        fd.rpb = p.in[11] + ((size_t)l * 8 + h) * 465;
      } else {
        const int q = it - N_MLA - N_NA;
        const int kind = q >> 6, u = q & 63, pair = u >> 1, qb = u & 1, b = pair >> 3, h = pair & 7;
        fd.nchunks = 4;
        if (kind == 0) {
          is96 = false;
          fd.q = NAQ + (size_t)(NLAT + b * CTX + qb * 128) * 512 + h * 64; fd.qstride = 512; fd.o = NAQ + (size_t)(NLAT + b * CTX + qb * 128) * 512 + h * 64;
          fd.kseq = NAK + (size_t)(NLAT + b * CTX) * 512 + h * 64; fd.kstride = 512; fd.vbase = NAVT + (size_t)pair * 64 * TALL;
        } else {
          is96 = true;
          fd.q = QF + (size_t)(NLAT + b * CTX + qb * 128) * 768 + h * 96; fd.qstride = 768; fd.o = OMLA + (size_t)(NLAT + b * CTX + qb * 128) * 512 + h * 64;
          fd.kseq = KF + (size_t)pair * TALL * 96; fd.kstride = 96; fd.vbase = VT + (size_t)pair * 64 * TALL;
        }
      }
      if (is96) flash_unit<96>(fd, smem); else flash_unit<64>(fd, smem);
    } else {
      const int q = it - n_flash, mt = q >> 2, g = q & 3, row0 = mt * 128;
      f32x4 acc[4][4]; zero_acc<4>(acc);
      gemm_mainloop<4, true>(acc, POOLD + (size_t)row0 * 512 + g * 128, 512, 3u, nullptr, WPL + (size_t)g * 128 * 128, 128, 128, smem);
      const float* psc = p.in[13] + l * 512 + g * 128;
#pragma unroll
      for (int n = 0; n < 4; ++n) {
        const float4 sc = *(const float4*)(psc + wc * 64 + n * 16 + fq * 4);
#pragma unroll
        for (int m = 0; m < 4; ++m) { acc[m][n][0] *= sc.x; acc[m][n][1] *= sc.y; acc[m][n][2] *= sc.z; acc[m][n][3] *= sc.w; }
      }
      bf16* db = OPOOL + (size_t)row0 * 512 + g * 128;
      epi_store<4, false>(acc, smem, [=](int r, int ch) -> bf16* { return db + (size_t)r * 512 + ch * 8; });
    }
  }
}

DEV void phase_merge(const Params& p, int l, int mtiles, unsigned char* smem) {
  TILE_IDS
  const bf16* H = (const bf16*)(p.ws + WS_H);
  const bf16* WG = (const bf16*)(p.ws + WS_W + (size_t)l * SZ_WL + O_WG);
  bf16* GATED = (bf16*)(p.ws + WS_GATED);
  const int nitems = mtiles * 8;
  for (int it = blockIdx.x; it < nitems; it += gridDim.x) {
    const int xq = it & 7, jq = it >> 3, mt = (jq >> 3) * 8 + xq, ntile = jq & 7, row0 = mt * 128, n0 = ntile * 128;
    f32x4 gsum[4][4]; zero_acc<4>(gsum);
#pragma unroll 1
    for (int k = 0; k < 3; ++k) {
      f32x4 ag[4][4]; zero_acc<4>(ag);
      gemm_mainloop<4, true>(ag, H + (size_t)row0 * D, D, 3u, nullptr, WG + (size_t)(k * 1024 + n0) * 1024, 1024, 1024, smem);
      const bf16* pb = (const bf16*)(p.ws + ((k == 0) ? WS_PB0 : ((k == 1) ? WS_PB1 : WS_PB2))) + (size_t)row0 * D + n0;
#pragma unroll
      for (int m = 0; m < 4; ++m)
#pragma unroll
        for (int n = 0; n < 4; ++n) {
          const uint2 u = *(const uint2*)(pb + (size_t)(wr * 64 + m * 16 + fr) * D + wc * 64 + n * 16 + fq * 4);
          const float p0 = __uint_as_float(u.x << 16), p1 = __uint_as_float(u.x & 0xffff0000u), p2 = __uint_as_float(u.y << 16), p3 = __uint_as_float(u.y & 0xffff0000u);
          gsum[m][n][0] += p0 * __builtin_amdgcn_rcpf(1.f + __expf(-ag[m][n][0])); gsum[m][n][1] += p1 * __builtin_amdgcn_rcpf(1.f + __expf(-ag[m][n][1]));
          gsum[m][n][2] += p2 * __builtin_amdgcn_rcpf(1.f + __expf(-ag[m][n][2])); gsum[m][n][3] += p3 * __builtin_amdgcn_rcpf(1.f + __expf(-ag[m][n][3]));
        }
    }
    bf16* db = GATED + (size_t)row0 * D + n0;
    epi_store<4, false>(gsum, smem, [=](int r, int ch) -> bf16* { return db + (size_t)r * D + ch * 8; });
  }
}

DEV void phase_gemm_out(const Params& p, const bf16* A, int lda, int K, const bf16* W, bf16* OUT, int mtiles, unsigned char* smem, int ngroups) {
  const int nbig = 128 * 8, per = nbig + (mtiles - 256) * 8, nitems = per * ngroups;
  for (int it = blockIdx.x; it < nitems; it += gridDim.x) {
    const int g = it / per, q = it - g * per;
    const bf16* Ag = A; const bf16* Wg = W; bf16* Og = OUT;
    if (ngroups == 3) {
      Ag = (const bf16*)(p.ws + ((g == 0) ? WS_NAQ : ((g == 1) ? WS_POOLU : WS_CQ)));
      Wg = W + (size_t)g * 1024 * 512;
      Og = (bf16*)(p.ws + ((g == 0) ? WS_PB0 : ((g == 1) ? WS_PB1 : WS_PB2)));
    }
    if (q < nbig) {
      const int xq = q & 7, jq = q >> 3, row0 = ((jq >> 3) * 8 + xq) * 256, n0 = (jq & 7) * 128;
      f32x4 acc[8][4]; zero_acc<8>(acc);
      gemm_mainloop<8, true>(acc, Ag + (size_t)row0 * lda, lda, 15u, nullptr, Wg + (size_t)n0 * K, K, K, smem);
      bf16* db = Og + (size_t)row0 * D + n0;
      epi_store<8, false>(acc, smem, [=](int r, int ch) -> bf16* { return db + (size_t)r * D + ch * 8; });
    } else {
      const int q2 = q - nbig, row0 = NLAT + (q2 >> 3) * 128, n0 = (q2 & 7) * 128;
      f32x4 acc[4][4]; zero_acc<4>(acc);
      gemm_mainloop<4, true>(acc, Ag + (size_t)row0 * lda, lda, 3u, nullptr, Wg + (size_t)n0 * K, K, K, smem);
      bf16* db = Og + (size_t)row0 * D + n0;
      epi_store<4, false>(acc, smem, [=](int r, int ch) -> bf16* { return db + (size_t)r * D + ch * 8; });
    }
  }
}

DEV void phase_ffn_up(const Params& p, int l, unsigned char* smem) {
  const int tid = ltid(), lane = tid & 63, wid = tid >> 6, wr = wid >> 1, wc = wid & 1, fr = lane & 15, fq = lane >> 4;
  const bf16* H = (const bf16*)(p.ws + WS_H);
  const bf16* WUP = (const bf16*)(p.ws + WS_W + (size_t)l * SZ_WL + O_WUP);
  bf16* ACT = (bf16*)(p.ws + WS_ACT);
  const float* cw = p.in[21] + (size_t)l * 3 * 2 * DFF; const float* cb = p.in[22] + (size_t)l * 2 * DFF;
  const int nmain = 8 * 2 * 44 * 8, nbig = nmain + 4 * 44;
  const int nitems = nbig + ((l == 0) ? 8 * 44 : 0);
  bf16* U = (bf16*)smem;
  for (int it = blockIdx.x; it < nitems; it += gridDim.x) {
    int sbase, L, ti, ntile;
    if (it < nbig) {
      int mi;
      if (it < nmain) { const int xq = it & 7, jq = it >> 3, ml = jq & 7, jn = jq >> 3; ntile = jn % 44; mi = ((jn / 44) * 8 + ml) * 8 + xq; }
      else { const int q = it - nmain; mi = 128 + q / 44; ntile = q % 44; }
      const int b = mi / 33; ti = mi % 33; sbase = b * SEQ; L = SEQ;
    } else { const int q2 = it - nbig, q = q2 / 44; ntile = q2 % 44; const int b = q >> 1; ti = q & 1; sbase = NLAT + b * CTX; L = CTX; }
    const int t0 = ti * 254;
    unsigned amask = 0;
#pragma unroll
    for (int i = 0; i < 4; ++i) { const int t = t0 - 1 + (tid >> 2) + 64 * i; amask |= (t >= 0 && t < L) ? (1u << i) : 0u; }
    f32x4 acc[8][4]; zero_acc<8>(acc);
    gemm_mainloop<8, true>(acc, H + ((ptrdiff_t)(sbase + t0 - 1)) * D, D, amask, (const bf16*)(p.ws + WS_BAR), WUP + (size_t)(ntile * 128) * 1024, 1024, 1024, smem);
#pragma unroll
    for (int m = 0; m < 8; ++m)
#pragma unroll
      for (int n = 0; n < 4; ++n) {
        uint2 o; o.x = pack2(acc[m][n][0], acc[m][n][1]); o.y = pack2(acc[m][n][2], acc[m][n][3]);
        *(uint2*)(U + (wr * 128 + m * 16 + fr) * 136 + wc * 64 + n * 16 + fq * 4) = o;
      }
    __syncthreads();
    {
      const int cq = (tid & 15) * 4, rg = tid >> 4, ca = ntile * 64 + cq, cbi = DFF + ca;
      const float4 wa0 = *(const float4*)(cw + ca), wa1 = *(const float4*)(cw + 2 * DFF + ca), wa2 = *(const float4*)(cw + 4 * DFF + ca), ba = *(const float4*)(cb + ca);
      const float4 wb0 = *(const float4*)(cw + cbi), wb1 = *(const float4*)(cw + 2 * DFF + cbi), wb2 = *(const float4*)(cw + 4 * DFF + cbi), bb = *(const float4*)(cb + cbi);
#define LD4(dst, ptr) { const uint2 u_ = *(const uint2*)(ptr); dst = make_float4(__uint_as_float(u_.x << 16), __uint_as_float(u_.x & 0xffff0000u), __uint_as_float(u_.y << 16), __uint_as_float(u_.y & 0xffff0000u)); }
      const int lr0 = rg * 16;
      float4 a0, a1, a2, b0, b1, b2;
      LD4(a0, U + max(lr0 - 1, 0) * 136 + cq) LD4(b0, U + max(lr0 - 1, 0) * 136 + 64 + cq)
      LD4(a1, U + lr0 * 136 + cq) LD4(b1, U + lr0 * 136 + 64 + cq)
      const float GC = -1.5957691216057308f * 1.4426950408889634f;
#pragma unroll 4
      for (int q = 0; q < 16; ++q) {
        const int lr = lr0 + q, t = t0 - 1 + lr;
        LD4(a2, U + min(lr + 1, 255) * 136 + cq) LD4(b2, U + min(lr + 1, 255) * 136 + 64 + cq)
        if (lr >= 1 && lr <= 254 && t < L) {
          float o[4];
#define CONV1(X) { const float av = fmaf(wa2.X, a2.X, fmaf(wa1.X, a1.X, fmaf(wa0.X, a0.X, ba.X))); const float bv = fmaf(wb2.X, b2.X, fmaf(wb1.X, b1.X, fmaf(wb0.X, b0.X, bb.X))); \
            const float u_ = av * fmaf(av * av, 0.044715f, 1.f); ov = av * bv * __builtin_amdgcn_rcpf(1.f + __builtin_amdgcn_exp2f(GC * u_)); }
          float ov;
          CONV1(x) o[0] = ov; CONV1(y) o[1] = ov; CONV1(z) o[2] = ov; CONV1(w) o[3] = ov;
#undef CONV1
          uint2 pk; pk.x = pack2(o[0], o[1]); pk.y = pack2(o[2], o[3]);
          *(uint2*)(ACT + (size_t)(sbase + t) * DFF + ca) = pk;
        }
        a0 = a1; a1 = a2; b0 = b1; b1 = b2;
      }
#undef LD4
    }
    __syncthreads();
  }
}

#define XB_TMO      128
#define XB_XCNT(j)  (256  + 64 * (j))
#define XB_XSUB(j)  (1280 + 64 * (j))
#define XB_XGEN(j)  (2304 + 64 * (j))
#define XB_TOP      3328
#define XB_TOPGEN   3392
#define XCD_BAR_WORDS 3456
#define XB_SPIN_CAP (1u << 18)
#define LAS __attribute__((address_space(3)))
DEV unsigned xb_ld(unsigned* p)              { return __hip_atomic_load(p, __ATOMIC_RELAXED, __HIP_MEMORY_SCOPE_AGENT); }
DEV unsigned xb_add(unsigned* p, unsigned v) { return __hip_atomic_fetch_add(p, v, __ATOMIC_RELAXED, __HIP_MEMORY_SCOPE_AGENT); }
DEV unsigned xb_xcc_id() { return (unsigned)__builtin_amdgcn_s_getreg((3 << 11) | 20) & 0xFu; }
#define XB_SPIN(cond, bar) do { unsigned _sp = 0; while (cond) { __builtin_amdgcn_s_sleep(1); \
    if ((++_sp & 255u) == 0u) { if (xb_ld(&(bar)[XB_TMO])) break; if (_sp > XB_SPIN_CAP) { atomicAdd(&(bar)[XB_TMO], 1u); break; } } } } while (0)
struct XcdBarrier { unsigned* bar; unsigned x; volatile LAS unsigned* st; };
DEV XcdBarrier xcd_barrier_post(unsigned* bar, volatile LAS unsigned* st) {
  XcdBarrier b; b.bar = bar; b.x = xb_xcc_id(); b.st = st;
  if (threadIdx.x == 0) (void)xb_add(&bar[XB_XCNT(b.x)], 1u);
  return b;
}
DEV void xcd_barrier_complete(unsigned* bar, unsigned x, unsigned& nloc, unsigned& nx) {
  const unsigned G = gridDim.x * gridDim.y * gridDim.z;
  unsigned sum, cnt, mine, sp = 0u;
  for (;;) {
    sum = 0u; cnt = 0u; mine = 0u;
#pragma unroll
    for (unsigned j = 0; j < 16; ++j) { const unsigned c = xb_ld(&bar[XB_XCNT(j)]); sum += c; cnt += (c > 0u) ? 1u : 0u; mine = (j == x) ? c : mine; }
    if (sum == G) break;
    __builtin_amdgcn_s_sleep(1);
    if ((++sp & 255u) == 0u) { if (xb_ld(&bar[XB_TMO])) break; if (sp > XB_SPIN_CAP) { atomicAdd(&bar[XB_TMO], 1u); break; } }
  }
  nloc = mine > 0u ? mine : 1u; nx = cnt > 0u ? cnt : 1u;
}
DEV void xcd_barrier(const XcdBarrier& b) {
  asm volatile("s_waitcnt vmcnt(0)" ::: "memory");
  __syncthreads();
  if (threadIdx.x == 0) {
    unsigned* bar = b.bar;
    __builtin_amdgcn_s_waitcnt(0);
    unsigned nloc = b.st[0], nx = b.st[1];
    if (nloc == 0u) { xcd_barrier_complete(bar, b.x, nloc, nx); b.st[0] = nloc; b.st[1] = nx; }
    const unsigned old = xb_add(&bar[XB_XSUB(b.x)], 1u);
    const unsigned gen = old / nloc;
    if (old + 1u == (gen + 1u) * nloc) {
      __builtin_amdgcn_fence(__ATOMIC_RELEASE, "agent");
      asm volatile("s_waitcnt vmcnt(0)" ::: "memory");
      const unsigned og = xb_add(&bar[XB_TOP], 1u);
      const unsigned tg = og / nx;
      if (og + 1u == (tg + 1u) * nx) xb_add(&bar[XB_TOPGEN], 1u);
      else XB_SPIN(xb_ld(&bar[XB_TOPGEN]) == tg, bar);
      __builtin_amdgcn_fence(__ATOMIC_ACQUIRE, "agent");
      xb_add(&bar[XB_XGEN(b.x)], 1u);
      asm volatile("s_waitcnt vmcnt(0)" ::: "memory");
    } else {
      XB_SPIN(xb_ld(&bar[XB_XGEN(b.x)]) == gen, bar);
      __builtin_amdgcn_fence(__ATOMIC_ACQUIRE, "agent");
      asm volatile("s_waitcnt vmcnt(0)" ::: "memory");
    }
  }
  __syncthreads();
}

constexpr int N_PHASES = 22;
DEV void run_phase(const Params& pin, int ph, unsigned char* smem) {
  Params p = pin;
  {
    size_t z = 0; asm volatile("" : "+s"(z));
    p.ws = pin.ws + z; p.out = pin.out + z;
  }
  if (ph == 0) { phase_prep(p, smem); return; }
  if (ph == 1) { phase_rows(p, 0, 0, MT); return; }
  const int l = (ph - 2) / 10, s = (ph - 2) % 10;
  const int mtiles = (l == 0) ? 264 : 256;
  const unsigned char* wl = p.ws + WS_W + (size_t)l * SZ_WL;
  switch (s) {
    case 0: phase_inproj(p, l, smem); break;
    case 1: phase_mlaproj(p, l, smem); break;
    case 2: phase_mixers(p, l, smem); break;
    case 3: phase_gemm_out(p, (const bf16*)(p.ws + WS_NAQ), 512, 512, (const bf16*)(wl + O_WBR), (bf16*)(p.ws + WS_PB0), mtiles, smem, 3); break;
    case 4: phase_merge(p, l, mtiles, smem); break;
    case 5: phase_gemm_out(p, (const bf16*)(p.ws + WS_GATED), D, D, (const bf16*)(wl + O_WO), (bf16*)(p.ws + WS_Y), mtiles, smem, 1); break;
    case 6: phase_rows(p, l, 1, mtiles * 128); break;
    case 7: phase_ffn_up(p, l, smem); break;
    case 8: phase_gemm_out(p, (const bf16*)(p.ws + WS_ACT), DFF, DFF, (const bf16*)(wl + O_WDN), (bf16*)(p.ws + WS_Y), mtiles, smem, 1); break;
    case 9: phase_rows(p, l, 2, mtiles * 128); break;
  }
}

__global__ void __launch_bounds__(256, 2) mega(Params p) {
  extern __shared__ __attribute__((aligned(16))) unsigned char smem[];
  volatile LAS unsigned* st = (volatile LAS unsigned*)(smem + LDS_GEMM + 1024);
  if (threadIdx.x == 0) { st[0] = 0u; st[1] = 0u; }
  __syncthreads();
  XcdBarrier xb;
  if (p.ph_hi - p.ph_lo > 1) xb = xcd_barrier_post((unsigned*)(p.ws + WS_BAR), st);
  for (int ph = p.ph_lo; ph < p.ph_hi; ++ph) {
    if (ph > p.ph_lo) {
      if (p.ph_hi > N_PHASES) cg::this_grid().sync();
      else xcd_barrier(xb);
    }
    run_phase(p, ph, smem);
  }
}

extern "C" void kernel_launch(void* const* d_in, const int* in_sizes, int n_in, void* d_out, int out_size, void* d_ws, size_t ws_size, hipStream_t stream) {
  static int grid = 0;
  if (grid == 0) {
    if (n_in != 24 || ws_size < WS_TOTAL) { fprintf(stderr, "kernel_launch: need 24 inputs and %zu bytes of workspace (got %d, %zu)\n", (size_t)WS_TOTAL, n_in, ws_size); grid = -1; return; }
    int dev = 0, cus = 0, per_cu = 0;
    hipGetDevice(&dev);
    hipDeviceGetAttribute(&cus, hipDeviceAttributeMultiprocessorCount, dev);
    if (hipFuncSetAttribute((const void*)mega, hipFuncAttributeMaxDynamicSharedMemorySize, LDS_BYTES) != hipSuccess) { fprintf(stderr, "hipFuncSetAttribute failed\n"); grid = -1; return; }
    if (hipOccupancyMaxActiveBlocksPerMultiprocessor(&per_cu, (const void*)mega, 256, LDS_BYTES) != hipSuccess || per_cu < 1) per_cu = 1;
    if (per_cu > 2) per_cu = 2;
    grid = cus * per_cu;
  }
  if (grid < 0) return;
  Params p{};
  for (int i = 0; i < 24; ++i) p.in[i] = (const float*)d_in[i];
  p.out = (float*)d_out; p.ws = (unsigned char*)d_ws;
#if ONE_LAUNCH
  if (hipMemsetAsync((unsigned char*)d_ws + WS_BAR, 0, XCD_BAR_WORDS * 4, stream) != hipSuccess) { fprintf(stderr, "barrier memset failed\n"); return; }
  p.ph_lo = 0; p.ph_hi = N_PHASES;
  void* args[] = {&p};
  hipError_t e = hipLaunchCooperativeKernel((const void*)mega, dim3(grid), dim3(256), args, LDS_BYTES, stream);
  if (e != hipSuccess) fprintf(stderr, "cooperative launch failed: %s (grid %d)\n", hipGetErrorString(e), grid);
#else
  for (int ph = 0; ph < N_PHASES; ++ph) {
    p.ph_lo = ph; p.ph_hi = ph + 1;
    hipLaunchKernelGGL(mega, dim3(grid), dim3(256), LDS_BYTES, stream, p);
  }
#endif
}
```
